# Optimizing an MI355X kernel written in HIP

```python
import math
import jax, jax.numpy as jnp
from jax import lax
import numpy as np

D_MODEL = 2048
BATCH = 2
SEQ = 16384
DEPTH = 1

HEAD_DIM = 128
DILATED_GROUPS = ((128, 1), (512, 4), (2048, 16))
N_GROUPS = len(DILATED_GROUPS)
HEADS_PER_GROUP = 4
N_ATTN_HEADS = N_GROUPS * HEADS_PER_GROUP
ATTN_WIDTH = N_ATTN_HEADS * HEAD_DIM
ATTN_OUT_WIDTH = HEADS_PER_GROUP * HEAD_DIM
CONV_DIM = D_MODEL
CONV_WIDTH = 3
D_FF = 5632
BLOCK = 128
RMS_EPS = 1e-6
NEG_INF = -1e30
ALIBI_SLOPES = tuple(2.0 ** (-8.0 * (i + 1) / N_ATTN_HEADS) for i in range(N_ATTN_HEADS))
IN_SIZES = (ATTN_WIDTH, ATTN_WIDTH, ATTN_WIDTH,
            CONV_DIM, CONV_DIM, CONV_DIM,
            D_MODEL, D_MODEL)
W_IN_COLS = sum(IN_SIZES)
SPLIT_POINTS = tuple(int(v) for v in np.cumsum(IN_SIZES)[:-1])

kernel_name = "hybrid_dilated_attn_shortconv_macaron"


def rms_norm(x, gain):
    xf = x.astype(jnp.float32)
    y = xf * lax.rsqrt(jnp.mean(xf * xf, axis=-1, keepdims=True) + RMS_EPS)
    return (y * gain.astype(jnp.float32)).astype(x.dtype)


def swiglu(x, w_gate, w_up, w_down):
    return (jax.nn.silu(x @ w_gate) * (x @ w_up)) @ w_down


def dilated_window_attention(q, k, v, slopes, window, dilation):
    b, s, h, dh = q.shape
    L = s // dilation
    w = window // dilation
    nb = -(-L // BLOCK)
    Lp = nb * BLOCK

    def to_sub(t):
        t = t.reshape(b, L, dilation, h, dh).transpose(0, 2, 3, 1, 4)
        return jnp.pad(t, ((0, 0), (0, 0), (0, 0), (0, Lp - L), (0, 0)))

    def band(t):
        t = jnp.pad(t, ((0, 0), (0, 0), (0, 0), (BLOCK, 0), (0, 0)))
        t = t.reshape(b, dilation, h, nb + 1, BLOCK, dh)
        return jnp.concatenate([t[:, :, :, :-1], t[:, :, :, 1:]], axis=4)

    qs, ks, vs = to_sub(q), to_sub(k), to_sub(v)
    qb = qs.reshape(b, dilation, h, nb, BLOCK, dh)
    kb, vb = band(ks), band(vs)

    scores = jnp.einsum('brhnqc,brhnkc->brhnqk', qb, kb).astype(jnp.float32)
    qi = jnp.arange(BLOCK)[:, None]
    ki = jnp.arange(2 * BLOCK)[None, :]
    dist = BLOCK + qi - ki
    key_pos = jnp.arange(nb)[:, None, None] * BLOCK + ki[None] - BLOCK
    valid = (dist >= 0) & (dist <= w) & (key_pos >= 0)
    slopes_arr = jnp.asarray(slopes, jnp.float32)
    alibi = -slopes_arr[:, None, None, None] * (dilation * dist).astype(jnp.float32)
    scores = jnp.where(valid, scores + alibi, NEG_INF)

    m = jnp.max(scores, axis=-1, keepdims=True)
    p = jnp.exp(scores - m)
    l = jnp.sum(p, axis=-1, keepdims=True)
    out = jnp.einsum('brhnqk,brhnkc->brhnqc', (p / l).astype(v.dtype), vb)
    lse = (m + jnp.log(l))[..., 0]

    out = out.reshape(b, dilation, h, Lp, dh)[:, :, :, :L]
    out = out.transpose(0, 3, 1, 2, 4).reshape(b, s, h, dh)
    lse = lse.reshape(b, dilation, h, Lp)[..., :L]
    lse = lse.transpose(0, 3, 1, 2).reshape(b, s, h)
    return out, lse


def causal_depthwise_conv(z, w):
    c = z.shape[-1]
    return lax.conv_general_dilated(
        z, w.reshape(CONV_WIDTH, 1, c).astype(z.dtype),
        window_strides=(1,), padding=((CONV_WIDTH - 1, 0),),
        dimension_numbers=('NWC', 'WIO', 'NWC'), feature_group_count=c)


def setup_inputs(seed: int = 0) -> dict:
    key = jax.random.key(seed)
    ks = jax.random.split(key, 20)
    f32 = jnp.float32

    def dense(k, fan_in, fan_out, scale=1.0):
        return jax.random.normal(k, (DEPTH, fan_in, fan_out), f32) * (scale * fan_in ** -0.5)

    def gain(k, shape):
        return 1.0 + 0.02 * jax.random.normal(k, (DEPTH,) + shape, f32)

    return {
        "x": jax.random.normal(ks[0], (BATCH, SEQ, D_MODEL), f32),
        "ffn1_norm": gain(ks[1], (D_MODEL,)),
        "ffn1_w_gate": dense(ks[2], D_MODEL, D_FF),
        "ffn1_w_up": dense(ks[3], D_MODEL, D_FF),
        "ffn1_w_down": dense(ks[4], D_FF, D_MODEL),
        "mix_norm": gain(ks[5], (D_MODEL,)),
        "w_in": dense(ks[6], D_MODEL, W_IN_COLS),
        "q_norm": gain(ks[7], (N_GROUPS, HEADS_PER_GROUP, HEAD_DIM)),
        "k_norm": gain(ks[8], (N_GROUPS, HEADS_PER_GROUP, HEAD_DIM)),
        "conv_w": jax.random.normal(ks[9], (DEPTH, CONV_WIDTH, CONV_DIM), f32) * CONV_WIDTH ** -0.5,
        "w_attn_out": dense(ks[10], ATTN_OUT_WIDTH, D_MODEL),
        "w_conv_out": dense(ks[11], CONV_DIM, D_MODEL),
        "w_o": dense(ks[12], D_MODEL, D_MODEL),
        "ffn2_norm": gain(ks[13], (D_MODEL,)),
        "ffn2_w_gate": dense(ks[14], D_MODEL, D_FF),
        "ffn2_w_up": dense(ks[15], D_MODEL, D_FF),
        "ffn2_w_down": dense(ks[16], D_FF, D_MODEL),
    }


def reference(x, ffn1_norm, ffn1_w_gate, ffn1_w_up, ffn1_w_down, mix_norm, w_in,
              q_norm, k_norm, conv_w, w_attn_out, w_conv_out, w_o,
              ffn2_norm, ffn2_w_gate, ffn2_w_up, ffn2_w_down):
    b, s, _ = x.shape
    for layer in range(DEPTH):
        x = x + 0.5 * swiglu(rms_norm(x, ffn1_norm[layer]),
                             ffn1_w_gate[layer], ffn1_w_up[layer], ffn1_w_down[layer])

        h = rms_norm(x, mix_norm[layer])
        proj = h @ w_in[layer]
        q, k, v, u, gate_b, gate_c, g_attn, g_conv = jnp.split(proj, SPLIT_POINTS, axis=-1)

        hshape = (b, s, N_GROUPS, HEADS_PER_GROUP, HEAD_DIM)
        q = rms_norm(q.reshape(hshape), q_norm[layer]) * (HEAD_DIM ** -0.5)
        k = rms_norm(k.reshape(hshape), k_norm[layer])
        v = v.reshape(hshape)
        outs, lses = [], []
        for g, (window, dilation) in enumerate(DILATED_GROUPS):
            slopes = ALIBI_SLOPES[g * HEADS_PER_GROUP:(g + 1) * HEADS_PER_GROUP]
            o_g, lse_g = dilated_window_attention(q[:, :, g], k[:, :, g], v[:, :, g],
                                                  slopes, window, dilation)
            outs.append(o_g)
            lses.append(lse_g)
        outs = jnp.stack(outs, axis=0)
        alpha = jax.nn.softmax(jnp.stack(lses, axis=0), axis=0)
        attn = jnp.sum(alpha[..., None].astype(outs.dtype) * outs, axis=0)
        branch_a = attn.reshape(b, s, ATTN_OUT_WIDTH) @ w_attn_out[layer]

        y = gate_b * causal_depthwise_conv(gate_c * u, conv_w[layer])
        branch_b = y @ w_conv_out[layer]

        merged = jax.nn.sigmoid(g_attn) * branch_a + jax.nn.sigmoid(g_conv) * branch_b
        x = x + merged @ w_o[layer]

        x = x + 0.5 * swiglu(rms_norm(x, ffn2_norm[layer]),
                             ffn2_w_gate[layer], ffn2_w_up[layer], ffn2_w_down[layer])
    return x
```

```cpp
#include <hip/hip_runtime.h>
#include <hip/hip_cooperative_groups.h>
#include <cstdio>
namespace cg = cooperative_groups;

#ifndef MULTI_LAUNCH
#define MULTI_LAUNCH 0
#endif

#define LAS __attribute__((address_space(3)))
typedef unsigned short bf16_t;
typedef short bf16x8 __attribute__((ext_vector_type(8)));
typedef float f32x4 __attribute__((ext_vector_type(4)));
typedef unsigned u32x4 __attribute__((ext_vector_type(4)));
typedef unsigned u32x2 __attribute__((ext_vector_type(2)));

constexpr int M = 32768, SEQ = 16384, D = 2048, FF = 5632, NQKV = 4608, NMIX = 10240, NIN = 14848, AW = 1536, AO = 512;
constexpr float EPS = 1e-6f;

constexpr size_t WS_W1GU = 0;
constexpr size_t WS_W1D = WS_W1GU + (size_t)2 * FF * D * 2;
constexpr size_t WS_WIN = WS_W1D + (size_t)D * FF * 2;
constexpr size_t WS_WAO = WS_WIN + (size_t)NIN * D * 2;
constexpr size_t WS_WCO = WS_WAO + (size_t)D * AO * 2;
constexpr size_t WS_WO = WS_WCO + (size_t)D * D * 2;
constexpr size_t WS_W2GU = WS_WO + (size_t)D * D * 2;
constexpr size_t WS_W2D = WS_W2GU + (size_t)2 * FF * D * 2;
constexpr size_t WS_XB = WS_W2D + (size_t)D * FF * 2;
constexpr size_t WS_RSS = WS_XB + (size_t)M * D * 2;
constexpr size_t WS_LSE = WS_RSS + (size_t)3 * M * 4;
constexpr size_t WS_ATT = WS_LSE + (size_t)3 * M * 4 * 4;
constexpr size_t WS_R = WS_ATT + (size_t)M * AO * 2;
constexpr size_t WS_Q = WS_R;
constexpr size_t WS_K = WS_Q + (size_t)M * AW * 2;
constexpr size_t WS_V = WS_K + (size_t)M * AW * 2;
constexpr size_t WS_CU = WS_K;
constexpr size_t WS_GB = WS_CU + (size_t)M * D * 2;
constexpr size_t WS_SGA = WS_GB + (size_t)M * D * 2;
constexpr size_t WS_SGC = WS_SGA + (size_t)M * D * 2;
constexpr size_t WS_HID = WS_R;
constexpr size_t WS_CWB = WS_SGC + (size_t)M * D * 2;
constexpr size_t WS_END = WS_CWB + 16384;

constexpr int LDS_BYTES = 143360;

__device__ __forceinline__ unsigned cvt_pk_bf16(float lo, float hi) { unsigned r; asm("v_cvt_pk_bf16_f32 %0, %1, %2" : "=v"(r) : "v"(lo), "v"(hi)); return r; }
__device__ __forceinline__ float bf_lo(unsigned w) { return __uint_as_float(w << 16); }
__device__ __forceinline__ float bf_hi(unsigned w) { return __uint_as_float(w & 0xffff0000u); }
__device__ __forceinline__ float fast_sigmoid(float v) { return __builtin_amdgcn_rcpf(1.0f + __expf(-v)); }
__device__ __forceinline__ size_t hb(int row, int col) { return ((size_t)(col >> 5) * M + row) * 32 + (col & 31); }
#define LDS_WAIT() asm volatile("s_waitcnt lgkmcnt(0)" ::: "memory")

namespace pg8 {
constexpr int BM = 256, BK = 64, HALF = 128, HTB = HALF * BK * 2, STAGE_BYTES = 8 * HTB, NXCD = 8, WGM = 8;
__host__ __device__ __forceinline__ int lds_byte(int r, int c) { const int st = (r >> 4) * 2 + (c >> 5), rr = r & 15, cc = c & 31, ob = rr * 64 + cc * 2; return st * 1024 + (ob ^ (((ob >> 9) & 1) << 5)); }
__host__ __device__ __forceinline__ void stage_rc(int b, int& R, int& C) { const int st = b / 1024, sb = b % 1024, swz = sb ^ (((sb >> 9) & 1) << 5); R = (st >> 1) * 16 + swz / 64; C = (st & 1) * 32 + (swz % 64) / 2; }
__host__ __device__ __forceinline__ int perm32(int rho) { const int n = rho >> 4, i = rho & 15; return 8 * (i >> 2) + 4 * n + (i & 3); }
struct Unit { int pm, pn; };
struct Gemm { const bf16_t* A; const bf16_t* Bt; int M, N, K; };
struct StaticOrder {
    int nM, nN, nwg, G, c;
    __device__ void init(int M_, int N_, int G_, int c_) { nM = M_ / BM; nN = N_ / BM; nwg = nM * nN; G = G_; c = c_; }
    __device__ bool next(int i, Unit& u) const {
        const long L = (long)i * G + c; if (L >= nwg) return false;
        int wgid = (int)L; { const int q = nwg / NXCD, r = nwg % NXCD, xcd = wgid % NXCD, off = wgid / NXCD; wgid = (xcd < r ? xcd * (q + 1) : r * (q + 1) + (xcd - r) * q) + off; }
        const int nig = WGM * nN, gid = wgid / nig, fm = gid * WGM, gsz = (nM - fm) < WGM ? (nM - fm) : WGM;
        u.pm = fm + ((wgid % nig) % gsz); u.pn = (wgid % nig) / gsz; return true;
    }
};
template <bool A_HB, class Epi>
__device__ __forceinline__ void gemm_phase(LAS unsigned char* lds, const Gemm g, const StaticOrder S, const Epi E) {
    const int tid = threadIdx.x, wid = __builtin_amdgcn_readfirstlane(tid >> 6), lane = tid & 63, wr = wid >> 2, wc = wid & 3, fr = lane & 15, fq = lane >> 4;
    const int K = g.K, nt = K / BK;
    unsigned voffA[2], voffB[2];
#pragma unroll
    for (int i = 0; i < 2; ++i) { int R, C; stage_rc(tid * 16 + i * 8192, R, C); const int Rb = (R & ~31) + perm32(R & 31);
        voffA[i] = A_HB ? (unsigned)(((C >> 5) * g.M + R) * 64 + (C & 31) * 2) : (unsigned)(R * K + C) * 2u; voffB[i] = (unsigned)(Rb * K + C) * 2u; }
    const size_t kstepB = (size_t)(BK * 2), kstepA = A_HB ? (size_t)g.M * 128 : kstepB;
    const size_t hstepB = (size_t)HALF * K * 2, hstepA = A_HB ? (size_t)HALF * 64 : hstepB;
    const size_t tstepA = 2 * hstepA, tstepB = 2 * hstepB;
    const unsigned ldsw = (unsigned)wid * 1024u;
    const int aoff = lds_byte(wr * 64 + fr, fq * 8), boff = lds_byte(wc * 32 + fr, fq * 8);
#define PG8_SA(b, h) (((b) * 2 + (h)) * HTB)
#define PG8_SB(b, h) ((4 + (b) * 2 + (h)) * HTB)
#define PG8_STAGE(bufoff, gbase, voff) do { _Pragma("unroll") for (int _i = 0; _i < 2; ++_i) \
        __builtin_amdgcn_global_load_lds((const unsigned*)((const char*)(gbase) + (voff)[_i]), (LAS unsigned*)(lds + (bufoff) + ldsw + _i * 8192), 16, 0, 0); } while (0)
#define PG8_LDA(dst, b, h) do { _Pragma("unroll") for (int m = 0; m < 4; ++m) _Pragma("unroll") for (int k = 0; k < 2; ++k) dst[m][k] = *(const LAS bf16x8*)(lds + PG8_SA(b, h) + aoff + m * 2048 + k * 1024); } while (0)
#define PG8_LDB(dst, b, h) do { _Pragma("unroll") for (int n = 0; n < 2; ++n) _Pragma("unroll") for (int k = 0; k < 2; ++k) dst[n][k] = *(const LAS bf16x8*)(lds + PG8_SB(b, h) + boff + n * 2048 + k * 1024); } while (0)
#define PG8_MMA(ai, bj, At, Bt) do { __builtin_amdgcn_s_setprio(1); _Pragma("unroll") for (int m = 0; m < 4; ++m) _Pragma("unroll") for (int n = 0; n < 2; ++n) _Pragma("unroll") for (int k = 0; k < 2; ++k) \
        acc[ai][bj][m][n] = __builtin_amdgcn_mfma_f32_16x16x32_bf16(Bt[n][k], At[m][k], acc[ai][bj][m][n], 0, 0, 0); __builtin_amdgcn_s_setprio(0); } while (0)
#define PG8_WAIT_V(n) asm volatile("s_waitcnt vmcnt(" #n ")" ::: "memory")
#define PG8_WAIT_L(n) asm volatile("s_waitcnt lgkmcnt(" #n ")" ::: "memory")
#define PG8_BAR __builtin_amdgcn_s_barrier()
#define PG8_SCHED __builtin_amdgcn_sched_barrier(0)
    Unit cur, nxt; int ui = 0;
    if (!S.next(0, cur)) return;
    f32x4 acc[2][2][4][2];
#pragma unroll
    for (int a = 0; a < 2; ++a)
#pragma unroll
        for (int b = 0; b < 2; ++b)
#pragma unroll
            for (int m = 0; m < 4; ++m)
#pragma unroll
                for (int n = 0; n < 2; ++n) acc[a][b][m][n] = (f32x4){0.f, 0.f, 0.f, 0.f};
    bf16x8 At[4][2], B0[2][2], B1[2][2];
    const char* cA = (const char*)g.A + (size_t)cur.pm * tstepA; const char* cB = (const char*)g.Bt + (size_t)cur.pn * tstepB;
    PG8_STAGE(PG8_SB(0, 0), cB, voffB); PG8_STAGE(PG8_SA(0, 0), cA, voffA); PG8_STAGE(PG8_SB(0, 1), cB + hstepB, voffB); PG8_STAGE(PG8_SA(0, 1), cA + hstepA, voffA);
    if (wr == 1) PG8_BAR;
    PG8_WAIT_V(4); PG8_BAR;
    PG8_STAGE(PG8_SB(1, 0), cB + kstepB, voffB); PG8_STAGE(PG8_SA(1, 0), cA + kstepA, voffA); PG8_STAGE(PG8_SB(1, 1), cB + hstepB + kstepB, voffB);
    PG8_WAIT_V(6); PG8_BAR;
    for (;;) {
        const bool has_next = S.next(ui + 1, nxt);
        const char* nA = has_next ? (const char*)g.A + (size_t)nxt.pm * tstepA : cA; const char* nB = has_next ? (const char*)g.Bt + (size_t)nxt.pn * tstepB : cB;
        for (int t = 0; t < nt; t += 2) {
            const bool last = (t == nt - 2);
            const char* a1 = cA + (size_t)(t + 1) * kstepA;
            const char* a2 = last ? nA : cA + (size_t)(t + 2) * kstepA; const char* b2 = last ? nB : cB + (size_t)(t + 2) * kstepB;
            const char* a3 = a2 + kstepA; const char* b3 = b2 + kstepB;
            PG8_LDB(B0, 0, 0); PG8_SCHED; PG8_LDA(At, 0, 0); PG8_STAGE(PG8_SA(1, 1), a1 + hstepA, voffA);
            PG8_WAIT_L(8); PG8_BAR; PG8_WAIT_L(0); PG8_MMA(0, 0, At, B0); PG8_BAR; PG8_SCHED;
            PG8_LDB(B1, 0, 1); PG8_STAGE(PG8_SB(0, 0), b2, voffB);
            PG8_BAR; PG8_WAIT_L(0); PG8_MMA(0, 1, At, B1); PG8_BAR;
            PG8_LDA(At, 0, 1); PG8_STAGE(PG8_SA(0, 0), a2, voffA);
            PG8_BAR; PG8_WAIT_L(0); PG8_MMA(1, 0, At, B0); PG8_BAR; PG8_SCHED;
            PG8_STAGE(PG8_SB(0, 1), b2 + hstepB, voffB);
            PG8_WAIT_V(6); PG8_BAR; PG8_MMA(1, 1, At, B1); PG8_BAR;
            PG8_LDB(B0, 1, 0); PG8_SCHED; PG8_LDA(At, 1, 0); PG8_STAGE(PG8_SA(0, 1), a2 + hstepA, voffA);
            PG8_WAIT_L(8); PG8_BAR; PG8_WAIT_L(0); PG8_MMA(0, 0, At, B0); PG8_BAR; PG8_SCHED;
            PG8_LDB(B1, 1, 1); PG8_STAGE(PG8_SB(1, 0), b3, voffB);
            PG8_BAR; PG8_WAIT_L(0); PG8_MMA(0, 1, At, B1); PG8_BAR;
            PG8_LDA(At, 1, 1); PG8_STAGE(PG8_SA(1, 0), a3, voffA);
            PG8_BAR; PG8_WAIT_L(0); PG8_MMA(1, 0, At, B0); PG8_BAR; PG8_SCHED;
            PG8_STAGE(PG8_SB(1, 1), b3 + hstepB, voffB);
            PG8_WAIT_V(6); PG8_BAR; PG8_MMA(1, 1, At, B1); PG8_BAR;
        }
        E(acc, cur, wr, wc, fr, fq);
        if (!has_next) break;
#pragma unroll
        for (int a = 0; a < 2; ++a)
#pragma unroll
            for (int b = 0; b < 2; ++b)
#pragma unroll
                for (int m = 0; m < 4; ++m)
#pragma unroll
                    for (int n = 0; n < 2; ++n) acc[a][b][m][n] = (f32x4){0.f, 0.f, 0.f, 0.f};
        cur = nxt; cA = nA; cB = nB; ++ui;
    }
    PG8_WAIT_V(0);
    if (wr == 0) PG8_BAR;
    PG8_BAR;
#undef PG8_SA
#undef PG8_SB
#undef PG8_STAGE
#undef PG8_LDA
#undef PG8_LDB
#undef PG8_MMA
#undef PG8_WAIT_V
#undef PG8_WAIT_L
#undef PG8_BAR
#undef PG8_SCHED
}
}
using pg8::Unit;
typedef f32x4 Acc[2][2][4][2];

__device__ __forceinline__ void load_rs8(const float* rss, int row0, float (&rs)[8]) {
#pragma unroll
    for (int i = 0; i < 8; ++i) rs[i] = rss[row0 + (i >> 2) * 128 + (i & 3) * 16];
#pragma unroll
    for (int i = 0; i < 8; ++i) rs[i] = rsqrtf(rs[i] * (1.0f / D) + EPS);
}
struct EpiSwiGLU {
    bf16_t* H; const float* rss;
    __device__ __forceinline__ void operator()(const Acc& acc, const Unit& u, int wr, int wc, int fr, int fq) const {
        const int row0 = u.pm * 256 + wr * 64 + fr, col0 = u.pn * 128 + wc * 32 + 8 * fq;
        float rsv[8]; load_rs8(rss, row0, rsv);
#pragma unroll
        for (int ai = 0; ai < 2; ++ai)
#pragma unroll
            for (int m = 0; m < 4; ++m) {
                const int row = row0 + ai * 128 + m * 16;
                const float rs = rsv[ai * 4 + m], nrl = -1.4426950408889634f * rs, rs2 = rs * rs;
                float h[8];
#pragma unroll
                for (int n = 0; n < 2; ++n)
#pragma unroll
                    for (int j = 0; j < 4; ++j) { const float ga = acc[ai][0][m][n][j], ua = acc[ai][1][m][n][j];
                        const float sg = __builtin_amdgcn_rcpf(1.0f + __builtin_amdgcn_exp2f(ga * nrl)); h[n * 4 + j] = (ga * ua) * rs2 * sg; }
                u32x4 w; w.x = cvt_pk_bf16(h[0], h[1]); w.y = cvt_pk_bf16(h[2], h[3]); w.z = cvt_pk_bf16(h[4], h[5]); w.w = cvt_pk_bf16(h[6], h[7]);
                *(u32x4*)(H + hb(row, col0)) = w;
            }
    }
};
template <int MODE> struct EpiResid {
    const float* base; float* out; bf16_t* xb; float* rss_out; float alpha;
    __device__ __forceinline__ void operator()(const Acc& acc, const Unit& u, int wr, int wc, int fr, int fq) const {
        const int row0 = u.pm * 256 + wr * 64 + fr, col0 = u.pn * 256 + wc * 32 + 8 * fq;
#pragma unroll
        for (int ai = 0; ai < 2; ++ai) {
            f32x4 b[4][2][2];
#pragma unroll
            for (int m = 0; m < 4; ++m)
#pragma unroll
                for (int bj = 0; bj < 2; ++bj) { const size_t off = (size_t)(row0 + ai * 128 + m * 16) * D + col0 + bj * 128;
                    if (MODE == 0) { b[m][bj][0] = *(const f32x4*)(base + off); b[m][bj][1] = *(const f32x4*)(base + off + 4); }
                    else { const u32x4 pw = *(const u32x4*)(xb + hb(row0 + ai * 128 + m * 16, col0 + bj * 128));
                        b[m][bj][0] = (f32x4){bf_lo(pw.x), bf_hi(pw.x), bf_lo(pw.y), bf_hi(pw.y)}; b[m][bj][1] = (f32x4){bf_lo(pw.z), bf_hi(pw.z), bf_lo(pw.w), bf_hi(pw.w)}; } }
#pragma unroll
            for (int m = 0; m < 4; ++m) {
                const int row = row0 + ai * 128 + m * 16; const size_t off = (size_t)row * D + col0;
                float ss = 0.f;
#pragma unroll
                for (int bj = 0; bj < 2; ++bj) {
                    const f32x4 v0 = b[m][bj][0] + alpha * acc[ai][bj][m][0], v1 = b[m][bj][1] + alpha * acc[ai][bj][m][1];
                    if (MODE == 2) { *(f32x4*)(out + off + bj * 128) = v0; *(f32x4*)(out + off + bj * 128 + 4) = v1; }
                    else {
                        u32x4 w; w.x = cvt_pk_bf16(v0[0], v0[1]); w.y = cvt_pk_bf16(v0[2], v0[3]); w.z = cvt_pk_bf16(v1[0], v1[1]); w.w = cvt_pk_bf16(v1[2], v1[3]);
                        *(u32x4*)(xb + hb(row, col0 + bj * 128)) = w;
                        const float r0 = bf_lo(w.x), r1 = bf_hi(w.x), r2 = bf_lo(w.y), r3 = bf_hi(w.y), r4 = bf_lo(w.z), r5 = bf_hi(w.z), r6 = bf_lo(w.w), r7 = bf_hi(w.w);
                        ss += (r0 * r0 + r1 * r1) + (r2 * r2 + r3 * r3) + (r4 * r4 + r5 * r5) + (r6 * r6 + r7 * r7);
                    }
                }
                if (MODE != 2) { ss += __shfl_xor(ss, 16); ss += __shfl_xor(ss, 32);
                    if (fq == 0) __hip_atomic_fetch_add(rss_out + row, ss, __ATOMIC_RELAXED, __HIP_MEMORY_SCOPE_AGENT); }
            }
            asm volatile("" ::: "memory");
        }
    }
};
struct EpiQKV {
    bf16_t* Q; const float* rss;
    __device__ __forceinline__ void operator()(const Acc& acc, const Unit& u, int wr, int wc, int fr, int fq) const {
        const int row0 = u.pm * 256 + wr * 64 + fr; const int t = u.pn / 6, colt = (u.pn - 6 * t) * 256;
        bf16_t* basep = Q + (size_t)t * ((size_t)M * AW); const int col0 = colt + wc * 32 + 8 * fq;
        float rsv[8]; load_rs8(rss, row0, rsv);
#pragma unroll
        for (int ai = 0; ai < 2; ++ai)
#pragma unroll
            for (int m = 0; m < 4; ++m) {
                const int row = row0 + ai * 128 + m * 16; const float rs = rsv[ai * 4 + m];
#pragma unroll
                for (int bj = 0; bj < 2; ++bj) { const f32x4 v0 = acc[ai][bj][m][0] * rs, v1 = acc[ai][bj][m][1] * rs;
                    u32x4 w; w.x = cvt_pk_bf16(v0[0], v0[1]); w.y = cvt_pk_bf16(v0[2], v0[3]); w.z = cvt_pk_bf16(v1[0], v1[1]); w.w = cvt_pk_bf16(v1[2], v1[3]);
                    *(u32x4*)(basep + (size_t)row * AW + col0 + bj * 128) = w; }
            }
    }
};
struct EpiCU {
    bf16_t* CU; const float* rss;
    __device__ __forceinline__ void operator()(const Acc& acc, const Unit& u, int wr, int wc, int fr, int fq) const {
        const int row0 = u.pm * 256 + wr * 64 + fr; const int col0 = u.pn * 128 + wc * 32 + 8 * fq;
        float rsv[8]; load_rs8(rss, row0, rsv);
#pragma unroll
        for (int ai = 0; ai < 2; ++ai)
#pragma unroll
            for (int m = 0; m < 4; ++m) {
                const int row = row0 + ai * 128 + m * 16; const float rs = rsv[ai * 4 + m]; const float rs2 = rs * rs;
                const f32x4 v0 = acc[ai][0][m][0] * acc[ai][1][m][0] * rs2, v1 = acc[ai][0][m][1] * acc[ai][1][m][1] * rs2;
                u32x4 w; w.x = cvt_pk_bf16(v0[0], v0[1]); w.y = cvt_pk_bf16(v0[2], v0[3]); w.z = cvt_pk_bf16(v1[0], v1[1]); w.w = cvt_pk_bf16(v1[2], v1[3]);
                *(u32x4*)(CU + hb(row, col0)) = w;
            }
    }
};
struct EpiGB {
    const bf16_t* CU; bf16_t* Y; unsigned char* SG; const bf16_t* CW; const float* rss;
    __device__ __forceinline__ void operator()(const Acc& acc, const Unit& u, int wr, int wc, int fr, int fq) const {
        const int row0 = u.pm * 256 + wr * 64 + fr; const int pn = u.pn;
        float rsv[8]; load_rs8(rss, row0, rsv);
        if (pn < 8) {
            const int col0 = pn * 256 + wc * 32 + 8 * fq;
#pragma unroll
            for (int bj = 0; bj < 2; ++bj) {
                const int col = col0 + bj * 128;
                const u32x4 t0 = *(const u32x4*)(CW + col), t1 = *(const u32x4*)(CW + D + col), t2 = *(const u32x4*)(CW + 2 * D + col);
#pragma unroll
                for (int ab = 0; ab < 4; ++ab) {
                    const int ai = ab >> 1, m0 = (ab & 1) * 2;
                    u32x4 c0[2], c1[2], c2[2];
#pragma unroll
                    for (int mm = 0; mm < 2; ++mm) { const int row = row0 + ai * 128 + (m0 + mm) * 16; const int tt = row & (SEQ - 1);
                        const bf16_t* p = CU + hb(row, col);
                        c0[mm] = *(const u32x4*)p; c1[mm] = *(const u32x4*)(p - (tt >= 1 ? 32 : 0)); c2[mm] = *(const u32x4*)(p - (tt >= 2 ? 64 : 0)); }
#pragma unroll
                    for (int mm = 0; mm < 2; ++mm) { const int m = m0 + mm; const int row = row0 + ai * 128 + m * 16; const int tt = row & (SEQ - 1); const float rs = rsv[ai * 4 + m];
                        const float k1 = tt >= 1 ? 1.f : 0.f, k2 = tt >= 2 ? 1.f : 0.f;
                        const f32x4 g0 = acc[ai][bj][m][0] * rs, g1 = acc[ai][bj][m][1] * rs;
                        float y[8];
#define CV(e, W, SEL, G) y[e] = (G) * (SEL(t2.W) * SEL(c0[mm].W) + k1 * SEL(t1.W) * SEL(c1[mm].W) + k2 * SEL(t0.W) * SEL(c2[mm].W))
                        CV(0, x, bf_lo, g0[0]); CV(1, x, bf_hi, g0[1]); CV(2, y, bf_lo, g0[2]); CV(3, y, bf_hi, g0[3]);
                        CV(4, z, bf_lo, g1[0]); CV(5, z, bf_hi, g1[1]); CV(6, w, bf_lo, g1[2]); CV(7, w, bf_hi, g1[3]);
#undef CV
                        u32x4 w; w.x = cvt_pk_bf16(y[0], y[1]); w.y = cvt_pk_bf16(y[2], y[3]); w.z = cvt_pk_bf16(y[4], y[5]); w.w = cvt_pk_bf16(y[6], y[7]);
                        *(u32x4*)(Y + hb(row, col)) = w; }
                    asm volatile("" ::: "memory");
                }
            }
        } else {
            const int ch0 = (pn - 8) * 128 + wc * 32 + 8 * fq;
#pragma unroll
            for (int ai = 0; ai < 2; ++ai)
#pragma unroll
                for (int m = 0; m < 4; ++m) {
                    const int row = row0 + ai * 128 + m * 16; const float rs = rsv[ai * 4 + m];
                    unsigned q[2][8];
#pragma unroll
                    for (int bj = 0; bj < 2; ++bj)
#pragma unroll
                        for (int n = 0; n < 2; ++n)
#pragma unroll
                            for (int j = 0; j < 4; ++j) q[bj][n * 4 + j] = (unsigned)__builtin_rintf(fast_sigmoid(acc[ai][bj][m][n][j] * rs) * 255.0f);
                    u32x4 w;
                    w.x = q[0][0] | (q[0][1] << 8) | (q[0][2] << 16) | (q[0][3] << 24); w.y = q[0][4] | (q[0][5] << 8) | (q[0][6] << 16) | (q[0][7] << 24);
                    w.z = q[1][0] | (q[1][1] << 8) | (q[1][2] << 16) | (q[1][3] << 24); w.w = q[1][4] | (q[1][5] << 8) | (q[1][6] << 16) | (q[1][7] << 24);
                    *(u32x4*)(SG + ((size_t)(ch0 >> 5) * M + row) * 64 + (size_t)((ch0 >> 3) & 3) * 16) = w;
                }
        }
    }
};
template <bool ADD> struct EpiMerge {
    bf16_t* MG; const bf16_t* gate;
    __device__ __forceinline__ void operator()(const Acc& acc, const Unit& u, int wr, int wc, int fr, int fq) const {
        const int row0 = u.pm * 256 + wr * 64 + fr, col0 = u.pn * 256 + wc * 32 + 8 * fq;
#pragma unroll
        for (int ai = 0; ai < 2; ++ai) {
            u32x2 gw[4][2]; u32x4 pw[4][2];
#pragma unroll
            for (int m = 0; m < 4; ++m)
#pragma unroll
                for (int bj = 0; bj < 2; ++bj) { const size_t off = (size_t)(row0 + ai * 128 + m * 16) * D + col0 + bj * 128;
                    gw[m][bj] = *(const u32x2*)((const unsigned char*)gate + ((size_t)((col0 + bj * 128) >> 5) * M + (row0 + ai * 128 + m * 16)) * 64 + (size_t)(((col0 + bj * 128) >> 3) & 3) * 16 + (ADD ? 8 : 0));
                    if (ADD) pw[m][bj] = *(const u32x4*)(MG + hb(row0 + ai * 128 + m * 16, col0 + bj * 128)); }
#pragma unroll
            for (int m = 0; m < 4; ++m)
#pragma unroll
                for (int bj = 0; bj < 2; ++bj) {
                    const size_t off = (size_t)(row0 + ai * 128 + m * 16) * D + col0 + bj * 128;
                    const u32x2 g = gw[m][bj]; constexpr float I255 = 1.0f / 255.0f;
                    f32x4 v0 = acc[ai][bj][m][0], v1 = acc[ai][bj][m][1];
                    v0[0] *= (float)(g.x & 0xffu) * I255; v0[1] *= (float)((g.x >> 8) & 0xffu) * I255; v0[2] *= (float)((g.x >> 16) & 0xffu) * I255; v0[3] *= (float)(g.x >> 24) * I255;
                    v1[0] *= (float)(g.y & 0xffu) * I255; v1[1] *= (float)((g.y >> 8) & 0xffu) * I255; v1[2] *= (float)((g.y >> 16) & 0xffu) * I255; v1[3] *= (float)(g.y >> 24) * I255;
                    if (ADD) { const u32x4 p = pw[m][bj];
                        v0[0] += bf_lo(p.x); v0[1] += bf_hi(p.x); v0[2] += bf_lo(p.y); v0[3] += bf_hi(p.y);
                        v1[0] += bf_lo(p.z); v1[1] += bf_hi(p.z); v1[2] += bf_lo(p.w); v1[3] += bf_hi(p.w); }
                    u32x4 w; w.x = cvt_pk_bf16(v0[0], v0[1]); w.y = cvt_pk_bf16(v0[2], v0[3]); w.z = cvt_pk_bf16(v1[0], v1[1]); w.w = cvt_pk_bf16(v1[2], v1[3]);
                    *(u32x4*)(MG + hb(row0 + ai * 128 + m * 16, col0 + bj * 128)) = w;
                }
            asm volatile("" ::: "memory");
        }
    }
};

__device__ __forceinline__ int map_row(int mode, int n) {
    if (mode == 0) return n;
    if (mode == 1) return (n >> 7) * 256 + (n & 127);
    if (mode == 2) return (n >> 7) * 256 + 128 + (n & 127);
    if (n < NQKV) return n;
    const int c = n - NQKV, seg = c >> 11, cc = c & 2047;
    if (seg == 0) return NQKV + (cc >> 7) * 256 + (cc & 127);
    if (seg == 2) return NQKV + (cc >> 7) * 256 + 128 + (cc & 127);
    if (seg == 1) return NQKV + 4096 + cc;
    if (seg == 3) return NQKV + 6144 + (cc >> 7) * 256 + (cc & 127);
    return NQKV + 6144 + (cc >> 7) * 256 + 128 + (cc & 127);
}
__device__ __forceinline__ void p0_item(const float* __restrict__ W, int K, int N, bf16_t* __restrict__ WT, const float* __restrict__ gain, int mode, LAS float* scr, int item, int lane) {
    const int nblk = N / 32, kb = item / nblk, nb = item - kb * nblk, k0 = 64 * kb, n0 = 32 * nb;
    const int rg = lane >> 3, c4 = (lane & 7) * 4;
    f32x4 v[8]; float gv[8];
#pragma unroll
    for (int i = 0; i < 8; ++i) { const int kk = 8 * i + rg; v[i] = *(const f32x4*)(W + (size_t)(k0 + kk) * N + n0 + c4); gv[i] = gain ? gain[k0 + kk] : 1.0f; }
#pragma unroll
    for (int i = 0; i < 8; ++i) { const int kk = 8 * i + rg; LAS float* d = scr + kk * 33 + c4; d[0] = v[i][0] * gv[i]; d[1] = v[i][1] * gv[i]; d[2] = v[i][2] * gv[i]; d[3] = v[i][3] * gv[i]; }
    LDS_WAIT();
    const int c = lane & 7; const int dr0 = map_row(mode, n0);
#pragma unroll
    for (int j = 0; j < 4; ++j) { const int n = (lane >> 3) + 8 * j; const LAS float* sp = scr + (8 * c) * 33 + n;
        u32x4 o; o.x = cvt_pk_bf16(sp[0 * 33], sp[1 * 33]); o.y = cvt_pk_bf16(sp[2 * 33], sp[3 * 33]); o.z = cvt_pk_bf16(sp[4 * 33], sp[5 * 33]); o.w = cvt_pk_bf16(sp[6 * 33], sp[7 * 33]);
        *(u32x4*)(WT + (size_t)(dr0 + n) * K + k0 + 8 * c) = o; }
    LDS_WAIT();
}

struct Args {
    const float* in[17]; float* out; unsigned char* ws; int ph_lo, ph_hi;
};

__device__ __forceinline__ void p0_phase(const Args& a, LAS unsigned char* lds, int G, int bid) {
    const int tid = threadIdx.x, lane = tid & 63, wave = tid >> 6;
    LAS float* scr = (LAS float*)(lds + wave * 8448);
    const int gw = bid * 8 + wave, NGW = G * 8;
    unsigned char* ws = a.ws;
    constexpr int I_GU = (D / 64) * (FF / 32), I_DN = (FF / 64) * (D / 32), I_IN = (D / 64) * (NIN / 32), I_AO = (AO / 64) * (D / 32), I_DD = (D / 64) * (D / 32);
    constexpr int NITEMS = 4 * I_GU + 2 * I_DN + I_IN + I_AO + 2 * I_DD;
    for (int it = gw; it < NITEMS; it += NGW) {
        int r = it;
        if (r < I_GU) { p0_item(a.in[2], D, FF, (bf16_t*)(ws + WS_W1GU), a.in[1], 1, scr, r, lane); continue; } r -= I_GU;
        if (r < I_GU) { p0_item(a.in[3], D, FF, (bf16_t*)(ws + WS_W1GU), a.in[1], 2, scr, r, lane); continue; } r -= I_GU;
        if (r < I_DN) { p0_item(a.in[4], FF, D, (bf16_t*)(ws + WS_W1D), nullptr, 0, scr, r, lane); continue; } r -= I_DN;
        if (r < I_IN) { p0_item(a.in[6], D, NIN, (bf16_t*)(ws + WS_WIN), a.in[5], 3, scr, r, lane); continue; } r -= I_IN;
        if (r < I_AO) { p0_item(a.in[10], AO, D, (bf16_t*)(ws + WS_WAO), nullptr, 0, scr, r, lane); continue; } r -= I_AO;
        if (r < I_DD) { p0_item(a.in[11], D, D, (bf16_t*)(ws + WS_WCO), nullptr, 0, scr, r, lane); continue; } r -= I_DD;
        if (r < I_DD) { p0_item(a.in[12], D, D, (bf16_t*)(ws + WS_WO), nullptr, 0, scr, r, lane); continue; } r -= I_DD;
        if (r < I_GU) { p0_item(a.in[14], D, FF, (bf16_t*)(ws + WS_W2GU), a.in[13], 1, scr, r, lane); continue; } r -= I_GU;
        if (r < I_GU) { p0_item(a.in[15], D, FF, (bf16_t*)(ws + WS_W2GU), a.in[13], 2, scr, r, lane); continue; } r -= I_GU;
        p0_item(a.in[16], FF, D, (bf16_t*)(ws + WS_W2D), nullptr, 0, scr, r, lane);
    }
    { bf16_t* CWB = (bf16_t*)(ws + WS_CWB); const float* cw = a.in[9];
      for (int i = gw * 64 + lane; i < 3 * D / 2; i += NGW * 64) ((unsigned*)CWB)[i] = cvt_pk_bf16(cw[2 * i], cw[2 * i + 1]); }
    const float* x = a.in[0]; bf16_t* XB = (bf16_t*)(ws + WS_XB); float* rss = (float*)(ws + WS_RSS);
    for (int rp = gw; rp < M / 2; rp += NGW) {
        const int row = 2 * rp + (lane >> 5), l5 = lane & 31;
        const f32x4* xr = (const f32x4*)(x + (size_t)row * D) + l5;
        f32x4 v[16]; float s = 0.f;
#pragma unroll
        for (int j = 0; j < 16; ++j) { v[j] = xr[32 * j]; s += (v[j][0] * v[j][0] + v[j][1] * v[j][1]) + (v[j][2] * v[j][2] + v[j][3] * v[j][3]); }
#pragma unroll
        for (int o = 1; o < 32; o <<= 1) s += __shfl_xor(s, o);
#pragma unroll
        for (int j = 0; j < 16; ++j) { u32x2 w; w.x = cvt_pk_bf16(v[j][0], v[j][1]); w.y = cvt_pk_bf16(v[j][2], v[j][3]); *(u32x2*)(XB + hb(row, 4 * l5 + 128 * j)) = w; }
        if (l5 == 0) { rss[row] = s; rss[M + row] = 0.f; rss[2 * M + row] = 0.f; }
    }
}

constexpr int KS_PITCH = 288, VS_PITCH = 544, VS_OFF = 256 * KS_PITCH;
__device__ __forceinline__ void attn_phase(LAS unsigned char* lds, bf16_t* Q, const bf16_t* Kg, const bf16_t* Vg, float* LSE, const float* qgain, const float* kgain, int G, int bid) {
    const int tid = threadIdx.x, wid = __builtin_amdgcn_readfirstlane(tid >> 6), lane = tid & 63, fr = lane & 15, fq = lane >> 4;
    LAS unsigned char* Ks = lds; LAS unsigned char* Vs = lds + VS_OFF;
    u32x4 kraw[8], vraw[8], qraw[4];
#define ATT_LOAD(uu) do { const int j_ = (uu) & 127, hh_ = ((uu) >> 7) % 12, b_ = (uu) / (128 * 12), g_ = hh_ >> 2; \
        const int ld_ = 2 * g_, d_ = 1 << ld_, r_ = j_ & (d_ - 1), n_ = j_ >> ld_; const size_t tok_ = (size_t)b_ * SEQ + r_; \
        _Pragma("unroll") for (int jj = 0; jj < 8; ++jj) { const int kk = (tid >> 4) + 32 * jj, ik = 128 * (n_ - 1) + kk; \
            kraw[jj] = (u32x4){0u, 0u, 0u, 0u}; if (ik >= 0) kraw[jj] = *(const u32x4*)(Kg + (tok_ + (size_t)ik * d_) * AW + hh_ * 128 + (tid & 15) * 8); } \
        _Pragma("unroll") for (int jj = 0; jj < 8; ++jj) { const int kk = (tid & 63) + 64 * (jj & 3), pc = (tid >> 6) + 8 * (jj >> 2), ik = 128 * (n_ - 1) + kk; \
            vraw[jj] = (u32x4){0u, 0u, 0u, 0u}; if (ik >= 0) vraw[jj] = *(const u32x4*)(Vg + (tok_ + (size_t)ik * d_) * AW + hh_ * 128 + pc * 8); } \
        } while (0)
    constexpr int NU = 2 * 12 * 128;
    if (bid < NU) ATT_LOAD(bid);
    for (int u = bid; u < NU; u += G) {
        const int j = u & 127, hh = (u >> 7) % 12, b = u / (128 * 12), g = hh >> 2;
        const int ld = 2 * g, d = 1 << ld, r = j & (d - 1), n = j >> ld;
        const size_t tok0 = (size_t)b * SEQ + r;
        const int qi = 16 * wid + fr; const size_t rowq = tok0 + (size_t)(128 * n + qi) * d;
#pragma unroll
        for (int ks = 0; ks < 4; ++ks) qraw[ks] = *(const u32x4*)(Q + rowq * AW + hh * 128 + 32 * ks + 8 * fq);
        __syncthreads();
        {
            const int piece = tid & 15;
            float kg[8];
#pragma unroll
            for (int e = 0; e < 8; ++e) kg[e] = kgain[hh * 128 + piece * 8 + e];
#pragma unroll
            for (int jj = 0; jj < 8; ++jj) {
                const int kk = (tid >> 4) + 32 * jj;
                const u32x4 raw = kraw[jj];
                float v[8] = {bf_lo(raw.x), bf_hi(raw.x), bf_lo(raw.y), bf_hi(raw.y), bf_lo(raw.z), bf_hi(raw.z), bf_lo(raw.w), bf_hi(raw.w)};
                float ss = 0.f;
#pragma unroll
                for (int e = 0; e < 8; ++e) ss += v[e] * v[e];
                ss += __shfl_xor(ss, 1); ss += __shfl_xor(ss, 2); ss += __shfl_xor(ss, 4); ss += __shfl_xor(ss, 8);
                const float rs = rsqrtf(ss * (1.0f / 128.0f) + EPS);
                u32x4 w; w.x = cvt_pk_bf16(v[0] * rs * kg[0], v[1] * rs * kg[1]); w.y = cvt_pk_bf16(v[2] * rs * kg[2], v[3] * rs * kg[3]);
                w.z = cvt_pk_bf16(v[4] * rs * kg[4], v[5] * rs * kg[5]); w.w = cvt_pk_bf16(v[6] * rs * kg[6], v[7] * rs * kg[7]);
                *(LAS u32x4*)(Ks + kk * KS_PITCH + piece * 16) = w;
            }
        }
        {
#pragma unroll
            for (int jj = 0; jj < 8; ++jj) {
                const int kk = (tid & 63) + 64 * (jj & 3), pc = (tid >> 6) + 8 * (jj >> 2);
                const u32x4 raw = vraw[jj];
                const int pk = (kk & ~31) + 8 * ((kk & 15) >> 2) + 4 * ((kk >> 4) & 1) + (kk & 3);
                LAS unsigned short* dst = (LAS unsigned short*)(Vs + (pc * 8) * VS_PITCH + pk * 2);
                dst[0 * (VS_PITCH / 2)] = (unsigned short)(raw.x & 0xffffu); dst[1 * (VS_PITCH / 2)] = (unsigned short)(raw.x >> 16);
                dst[2 * (VS_PITCH / 2)] = (unsigned short)(raw.y & 0xffffu); dst[3 * (VS_PITCH / 2)] = (unsigned short)(raw.y >> 16);
                dst[4 * (VS_PITCH / 2)] = (unsigned short)(raw.z & 0xffffu); dst[5 * (VS_PITCH / 2)] = (unsigned short)(raw.z >> 16);
                dst[6 * (VS_PITCH / 2)] = (unsigned short)(raw.w & 0xffffu); dst[7 * (VS_PITCH / 2)] = (unsigned short)(raw.w >> 16);
            }
        }
        bf16x8 qf[4];
        {
            float ss = 0.f;
#pragma unroll
            for (int ks = 0; ks < 4; ++ks) {
                const float v[8] = {bf_lo(qraw[ks].x), bf_hi(qraw[ks].x), bf_lo(qraw[ks].y), bf_hi(qraw[ks].y), bf_lo(qraw[ks].z), bf_hi(qraw[ks].z), bf_lo(qraw[ks].w), bf_hi(qraw[ks].w)};
#pragma unroll
                for (int e = 0; e < 8; ++e) ss += v[e] * v[e]; }
            ss += __shfl_xor(ss, 16); ss += __shfl_xor(ss, 32);
            const float rs = rsqrtf(ss * (1.0f / 128.0f) + EPS) * 0.08838834764831845f;
#pragma unroll
            for (int ks = 0; ks < 4; ++ks) {
                const float* gp = qgain + hh * 128 + 32 * ks + 8 * fq;
                const f32x4 g0 = *(const f32x4*)gp, g1 = *(const f32x4*)(gp + 4);
                u32x4 w; w.x = cvt_pk_bf16(bf_lo(qraw[ks].x) * rs * g0[0], bf_hi(qraw[ks].x) * rs * g0[1]); w.y = cvt_pk_bf16(bf_lo(qraw[ks].y) * rs * g0[2], bf_hi(qraw[ks].y) * rs * g0[3]);
                w.z = cvt_pk_bf16(bf_lo(qraw[ks].z) * rs * g1[0], bf_hi(qraw[ks].z) * rs * g1[1]); w.w = cvt_pk_bf16(bf_lo(qraw[ks].w) * rs * g1[2], bf_hi(qraw[ks].w) * rs * g1[3]);
                qf[ks] = __builtin_bit_cast(bf16x8, w);
            }
        }
        if (u + G < NU) ATT_LOAD(u + G);
        LDS_WAIT();
        __syncthreads();
        const int T0 = 2 * (wid >> 1);
        f32x4 s[10];
#pragma unroll
        for (int t = 0; t < 10; ++t) { s[t] = (f32x4){0.f, 0.f, 0.f, 0.f};
#pragma unroll
            for (int ks = 0; ks < 4; ++ks) { const bf16x8 a = *(const LAS bf16x8*)(Ks + (16 * (T0 + t) + fr) * KS_PITCH + (32 * ks + 8 * fq) * 2);
                s[t] = __builtin_amdgcn_mfma_f32_16x16x32_bf16(a, qf[ks], s[t], 0, 0, 0); } }
        const float slope = exp2f(-8.0f * (float)(hh + 1) / 12.0f) * (float)d;
        float mx = -3.0e38f;
#pragma unroll
        for (int t = 0; t < 10; ++t)
#pragma unroll
            for (int e = 0; e < 4; ++e) { const int ki = 16 * (T0 + t) + 4 * fq + e, dist = 128 + qi - ki;
                const bool valid = (dist >= 0) && (dist <= 128) && (n > 0 || ki >= 128);
                const float sv = valid ? s[t][e] - slope * (float)dist : -1.0e30f; s[t][e] = sv; mx = fmaxf(mx, sv); }
        mx = fmaxf(mx, __shfl_xor(mx, 16)); mx = fmaxf(mx, __shfl_xor(mx, 32));
        float l = 0.f;
#pragma unroll
        for (int t = 0; t < 10; ++t)
#pragma unroll
            for (int e = 0; e < 4; ++e) { const float p = __expf(s[t][e] - mx); s[t][e] = p; l += p; }
        l += __shfl_xor(l, 16); l += __shfl_xor(l, 32);
        f32x4 o[8];
#pragma unroll
        for (int dt = 0; dt < 8; ++dt) o[dt] = (f32x4){0.f, 0.f, 0.f, 0.f};
#pragma unroll
        for (int c = 0; c < 5; ++c) {
            u32x4 pw; pw.x = cvt_pk_bf16(s[2 * c][0], s[2 * c][1]); pw.y = cvt_pk_bf16(s[2 * c][2], s[2 * c][3]); pw.z = cvt_pk_bf16(s[2 * c + 1][0], s[2 * c + 1][1]); pw.w = cvt_pk_bf16(s[2 * c + 1][2], s[2 * c + 1][3]);
            const bf16x8 pb = __builtin_bit_cast(bf16x8, pw);
#pragma unroll
            for (int dt = 0; dt < 8; ++dt) { const bf16x8 a = *(const LAS bf16x8*)(Vs + (16 * dt + fr) * VS_PITCH + (32 * ((T0 >> 1) + c) + 8 * fq) * 2);
                o[dt] = __builtin_amdgcn_mfma_f32_16x16x32_bf16(a, pb, o[dt], 0, 0, 0); }
        }
        const float inv = 1.0f / l;
#pragma unroll
        for (int dt = 0; dt < 8; ++dt) { u32x2 w; w.x = cvt_pk_bf16(o[dt][0] * inv, o[dt][1] * inv); w.y = cvt_pk_bf16(o[dt][2] * inv, o[dt][3] * inv);
            *(u32x2*)(Q + rowq * AW + hh * 128 + 16 * dt + 4 * fq) = w; }
        if (fq == 0) LSE[((size_t)g * M + rowq) * 4 + (hh & 3)] = mx + __logf(l);
    }
}

#undef ATT_LOAD
__device__ __forceinline__ void combine_phase(const bf16_t* __restrict__ OG, const float* __restrict__ LSE, bf16_t* __restrict__ ATT, int G, int bid) {
    const int nthr = G * 512;
    for (int it0 = bid * 512 + threadIdx.x; it0 < M * 64; it0 += 4 * nthr) {
        float l0[4], l1[4], l2[4]; u32x4 w0[4], w1[4], w2[4];
#pragma unroll
        for (int q = 0; q < 4; ++q) { const int it = it0 + q * nthr; if (it < M * 64) {
            const int t = (it >> 2) & (M - 1), c8 = ((it >> 17) << 2) | (it & 3), h = c8 >> 4;
            l0[q] = LSE[((size_t)0 * M + t) * 4 + h]; l1[q] = LSE[((size_t)1 * M + t) * 4 + h]; l2[q] = LSE[((size_t)2 * M + t) * 4 + h];
            const bf16_t* p = OG + (size_t)t * AW + h * 128 + (c8 & 15) * 8;
            w0[q] = *(const u32x4*)p; w1[q] = *(const u32x4*)(p + 512); w2[q] = *(const u32x4*)(p + 1024); } }
#pragma unroll
        for (int q = 0; q < 4; ++q) { const int it = it0 + q * nthr; if (it < M * 64) {
            const int t = (it >> 2) & (M - 1), c8 = ((it >> 17) << 2) | (it & 3);
            const float mx = fmaxf(l0[q], fmaxf(l1[q], l2[q]));
            float a0 = __expf(l0[q] - mx), a1 = __expf(l1[q] - mx), a2 = __expf(l2[q] - mx); const float inv = 1.0f / (a0 + a1 + a2); a0 *= inv; a1 *= inv; a2 *= inv;
            const u32x4 x0 = w0[q], x1 = w1[q], x2 = w2[q];
            u32x4 o;
            o.x = cvt_pk_bf16(a0 * bf_lo(x0.x) + a1 * bf_lo(x1.x) + a2 * bf_lo(x2.x), a0 * bf_hi(x0.x) + a1 * bf_hi(x1.x) + a2 * bf_hi(x2.x));
            o.y = cvt_pk_bf16(a0 * bf_lo(x0.y) + a1 * bf_lo(x1.y) + a2 * bf_lo(x2.y), a0 * bf_hi(x0.y) + a1 * bf_hi(x1.y) + a2 * bf_hi(x2.y));
            o.z = cvt_pk_bf16(a0 * bf_lo(x0.z) + a1 * bf_lo(x1.z) + a2 * bf_lo(x2.z), a0 * bf_hi(x0.z) + a1 * bf_hi(x1.z) + a2 * bf_hi(x2.z));
            o.w = cvt_pk_bf16(a0 * bf_lo(x0.w) + a1 * bf_lo(x1.w) + a2 * bf_lo(x2.w), a0 * bf_hi(x0.w) + a1 * bf_hi(x1.w) + a2 * bf_hi(x2.w));
            *(u32x4*)(ATT + hb(t, c8 * 8)) = o; } }
    }
}

constexpr int N_PHASES = 11;
template <bool COOP>
__global__ void __launch_bounds__(512, 2) fwd_kernel(Args a) {
    extern __shared__ __attribute__((aligned(16))) unsigned char lds_raw[];
    LAS unsigned char* lds = (LAS unsigned char*)lds_raw;
    const int G = gridDim.x, bid = blockIdx.x;
    unsigned char* ws = a.ws;
    bf16_t* XB = (bf16_t*)(ws + WS_XB); float* rss = (float*)(ws + WS_RSS); bf16_t* HID = (bf16_t*)(ws + WS_HID);
    const int lo = a.ph_lo, hi = a.ph_hi;
#define IN(k) (lo <= (k) && (k) < hi)
#define SEAM(k) do { if (COOP) { if (IN(k) && IN((k) + 1)) cg::this_grid().sync(); } } while (0)
    if (IN(0)) { p0_phase(a, lds, G, bid); __syncthreads(); }
    SEAM(0);
    if (IN(1)) {
        pg8::Gemm g{XB, (const bf16_t*)(ws + WS_W1GU), M, 2 * FF, D}; pg8::StaticOrder S; S.init(M, 2 * FF, G, bid);
        EpiSwiGLU E{HID, rss};
        pg8::gemm_phase<true>(lds, g, S, E);
    }
    SEAM(1);
    if (IN(2)) {
        pg8::Gemm g{HID, (const bf16_t*)(ws + WS_W1D), M, D, FF}; pg8::StaticOrder S; S.init(M, D, G, bid);
        EpiResid<0> E{a.in[0], nullptr, XB, rss + M, 0.5f};
        pg8::gemm_phase<true>(lds, g, S, E);
    }
    SEAM(2);
    if (IN(3)) {
        pg8::Gemm g{XB, (const bf16_t*)(ws + WS_WIN), M, NQKV, D}; pg8::StaticOrder S; S.init(M, NQKV, G, bid);
        EpiQKV E{(bf16_t*)(ws + WS_Q), rss + M};
        pg8::gemm_phase<true>(lds, g, S, E);
    }
    SEAM(3);
    if (IN(4)) attn_phase(lds, (bf16_t*)(ws + WS_Q), (const bf16_t*)(ws + WS_K), (const bf16_t*)(ws + WS_V), (float*)(ws + WS_LSE), a.in[7], a.in[8], G, bid);
    SEAM(4);
    if (IN(5)) {
        combine_phase((const bf16_t*)(ws + WS_Q), (const float*)(ws + WS_LSE), (bf16_t*)(ws + WS_ATT), G, bid);
        __syncthreads();
        pg8::Gemm g{XB, (const bf16_t*)(ws + WS_WIN) + (size_t)NQKV * D, M, 4096, D}; pg8::StaticOrder S; S.init(M, 4096, G, bid);
        EpiCU E{(bf16_t*)(ws + WS_CU), rss + M};
        pg8::gemm_phase<true>(lds, g, S, E);
    }
    SEAM(5);
    if (IN(6)) {
        pg8::Gemm g{XB, (const bf16_t*)(ws + WS_WIN) + (size_t)(NQKV + 4096) * D, M, 6144, D}; pg8::StaticOrder S; S.init(M, 6144, G, bid);
        EpiGB E{(const bf16_t*)(ws + WS_CU), (bf16_t*)(ws + WS_GB), (unsigned char*)(ws + WS_SGA), (const bf16_t*)(ws + WS_CWB), rss + M};
        pg8::gemm_phase<true>(lds, g, S, E);
    }
    SEAM(6);
    if (IN(7)) {
        { pg8::Gemm g{(const bf16_t*)(ws + WS_ATT), (const bf16_t*)(ws + WS_WAO), M, D, AO}; pg8::StaticOrder S; S.init(M, D, G, bid);
          EpiMerge<false> E{(bf16_t*)(ws + WS_CU), (const bf16_t*)(ws + WS_SGA)};
          pg8::gemm_phase<true>(lds, g, S, E); }
        { pg8::Gemm g{(const bf16_t*)(ws + WS_GB), (const bf16_t*)(ws + WS_WCO), M, D, D}; pg8::StaticOrder S; S.init(M, D, G, bid);
          EpiMerge<true> E{(bf16_t*)(ws + WS_CU), (const bf16_t*)(ws + WS_SGA)};
          pg8::gemm_phase<true>(lds, g, S, E); }
    }
    SEAM(7);
    if (IN(8)) {
        pg8::Gemm g{(const bf16_t*)(ws + WS_CU), (const bf16_t*)(ws + WS_WO), M, D, D}; pg8::StaticOrder S; S.init(M, D, G, bid);
        EpiResid<1> E{nullptr, nullptr, XB, rss + 2 * M, 1.0f};
        pg8::gemm_phase<true>(lds, g, S, E);
    }
    SEAM(8);
    if (IN(9)) {
        pg8::Gemm g{XB, (const bf16_t*)(ws + WS_W2GU), M, 2 * FF, D}; pg8::StaticOrder S; S.init(M, 2 * FF, G, bid);
        EpiSwiGLU E{HID, rss + 2 * M};
        pg8::gemm_phase<true>(lds, g, S, E);
    }
    SEAM(9);
    if (IN(10)) {
        pg8::Gemm g{HID, (const bf16_t*)(ws + WS_W2D), M, D, FF}; pg8::StaticOrder S; S.init(M, D, G, bid);
        EpiResid<2> E{nullptr, a.out, XB, nullptr, 0.5f};
        pg8::gemm_phase<true>(lds, g, S, E);
    }
#undef IN
#undef SEAM
}

extern "C" void kernel_launch(void* const* d_in, const int* in_sizes, int n_in, void* d_out, int out_size, void* d_ws, size_t ws_size, hipStream_t stream) {
    static int grid = 0;
    constexpr bool COOP = (MULTI_LAUNCH == 0);
    if (grid == 0) {
        if (n_in != 17 || ws_size < WS_END) { fprintf(stderr, "kernel_launch: unexpected n_in %d or ws_size %zu (< %zu)\n", n_in, ws_size, (size_t)WS_END); grid = -1; return; }
        int dev = 0, cus = 0, per_cu = 0;
        hipGetDevice(&dev); hipDeviceGetAttribute(&cus, hipDeviceAttributeMultiprocessorCount, dev);
        hipFuncSetAttribute((const void*)fwd_kernel<COOP>, hipFuncAttributeMaxDynamicSharedMemorySize, LDS_BYTES);
        hipOccupancyMaxActiveBlocksPerMultiprocessor(&per_cu, (const void*)fwd_kernel<COOP>, 512, LDS_BYTES);
        if (per_cu < 1) { fprintf(stderr, "kernel_launch: occupancy query says %d blocks/CU\n", per_cu); per_cu = 1; }
        (void)hipGetLastError();
        grid = cus * 1;
    }
    if (grid < 0) return;
    Args a{};
    for (int i = 0; i < 17; ++i) a.in[i] = (const float*)d_in[i];
    a.out = (float*)d_out; a.ws = (unsigned char*)d_ws;
    if (COOP) {
        a.ph_lo = 0; a.ph_hi = N_PHASES;
        void* args[] = {&a};
        hipError_t e = hipLaunchCooperativeKernel((const void*)fwd_kernel<COOP>, dim3(grid), dim3(512), args, LDS_BYTES, stream);
        if (e != hipSuccess) fprintf(stderr, "cooperative launch failed: %s (grid %d)\n", hipGetErrorString(e), grid);
    } else {
        for (int p = 0; p < N_PHASES; ++p) {
            a.ph_lo = p; a.ph_hi = p + 1;
            hipLaunchKernelGGL(fwd_kernel<COOP>, dim3(grid), dim3(512), LDS_BYTES, stream, a);
        }
    }
}
```

```cpp
#include <hip/hip_runtime.h>
#include <hip/hip_cooperative_groups.h>
#include <cstdio>
namespace cg = cooperative_groups;

#ifndef MULTI_LAUNCH
#define MULTI_LAUNCH 0
#endif

#define LAS __attribute__((address_space(3)))
typedef unsigned short bf16_t;
typedef short bf16x8 __attribute__((ext_vector_type(8)));
typedef float f32x4 __attribute__((ext_vector_type(4)));
typedef unsigned u32x4 __attribute__((ext_vector_type(4)));
typedef unsigned u32x2 __attribute__((ext_vector_type(2)));

constexpr int M = 32768, SEQ = 16384, D = 2048, FF = 5632, NQKV = 4608, NMIX = 10240, NIN = 14848, AW = 1536, AO = 512;
constexpr float EPS = 1e-6f;

constexpr size_t WS_W1GU = 0;
constexpr size_t WS_W1D = WS_W1GU + (size_t)2 * FF * D * 2;
constexpr size_t WS_WIN = WS_W1D + (size_t)D * FF * 2;
constexpr size_t WS_WAO = WS_WIN + (size_t)NIN * D * 2;
constexpr size_t WS_WCO = WS_WAO + (size_t)D * AO * 2;
constexpr size_t WS_WO = WS_WCO + (size_t)D * D * 2;
constexpr size_t WS_W2GU = WS_WO + (size_t)D * D * 2;
constexpr size_t WS_W2D = WS_W2GU + (size_t)2 * FF * D * 2;
constexpr size_t WS_XB = WS_W2D + (size_t)D * FF * 2;
constexpr size_t WS_RSS = WS_XB + (size_t)M * D * 2;
constexpr size_t WS_LSE = WS_RSS + (size_t)3 * M * 4;
constexpr size_t WS_ATT = WS_LSE + (size_t)3 * M * 4 * 4;
constexpr size_t WS_R = WS_ATT + (size_t)M * AO * 2;
constexpr size_t WS_Q = WS_R;
constexpr size_t WS_K = WS_Q + (size_t)M * AW * 2;
constexpr size_t WS_V = WS_K + (size_t)M * AW * 2;
constexpr size_t WS_CU = WS_K;
constexpr size_t WS_GB = WS_CU + (size_t)M * D * 2;
constexpr size_t WS_SGA = WS_GB + (size_t)M * D * 2;
constexpr size_t WS_SGC = WS_SGA + (size_t)M * D * 2;
constexpr size_t WS_CU2 = WS_SGA;
constexpr size_t WS_SG8 = WS_SGC;
constexpr size_t WS_HID = WS_R;
constexpr size_t WS_CWB = WS_SGC + (size_t)M * D * 2;
constexpr size_t WS_END = WS_CWB + 16384;

constexpr int LDS_BYTES = 143360;

__device__ __forceinline__ unsigned cvt_pk_bf16(float lo, float hi) { unsigned r; asm("v_cvt_pk_bf16_f32 %0, %1, %2" : "=v"(r) : "v"(lo), "v"(hi)); return r; }
__device__ __forceinline__ float bf_lo(unsigned w) { return __uint_as_float(w << 16); }
__device__ __forceinline__ float bf_hi(unsigned w) { return __uint_as_float(w & 0xffff0000u); }
__device__ __forceinline__ float fast_sigmoid(float v) { return __builtin_amdgcn_rcpf(1.0f + __expf(-v)); }
__device__ __forceinline__ size_t hb(int row, int col) { return ((size_t)(col >> 5) * M + row) * 32 + (col & 31); }
#define LDS_WAIT() asm volatile("s_waitcnt lgkmcnt(0)" ::: "memory")

namespace pg8 {
constexpr int BM = 256, BK = 64, HALF = 128, HTB = HALF * BK * 2, STAGE_BYTES = 8 * HTB, NXCD = 8, WGM = 8;
__host__ __device__ __forceinline__ int lds_byte(int r, int c) { const int st = (r >> 4) * 2 + (c >> 5), rr = r & 15, cc = c & 31, ob = rr * 64 + cc * 2; return st * 1024 + (ob ^ (((ob >> 9) & 1) << 5)); }
__host__ __device__ __forceinline__ void stage_rc(int b, int& R, int& C) { const int st = b / 1024, sb = b % 1024, swz = sb ^ (((sb >> 9) & 1) << 5); R = (st >> 1) * 16 + swz / 64; C = (st & 1) * 32 + (swz % 64) / 2; }
__host__ __device__ __forceinline__ int perm32(int rho) { const int n = rho >> 4, i = rho & 15; return 8 * (i >> 2) + 4 * n + (i & 3); }
struct Unit { int pm, pn; };
struct Gemm { const bf16_t* A; const bf16_t* Bt; int M, N, K; };
struct StaticOrder {
    int nM, nN, nwg, G, c;
    __device__ void init(int M_, int N_, int G_, int c_) { nM = M_ / BM; nN = N_ / BM; nwg = nM * nN; G = G_; c = c_; }
    __device__ bool next(int i, Unit& u) const {
        const long L = (long)i * G + c; if (L >= nwg) return false;
        int wgid = (int)L; { const int q = nwg / NXCD, r = nwg % NXCD, xcd = wgid % NXCD, off = wgid / NXCD; wgid = (xcd < r ? xcd * (q + 1) : r * (q + 1) + (xcd - r) * q) + off; }
        const int nig = WGM * nN, gid = wgid / nig, fm = gid * WGM, gsz = (nM - fm) < WGM ? (nM - fm) : WGM;
        u.pm = fm + ((wgid % nig) % gsz); u.pn = (wgid % nig) / gsz; return true;
    }
};
template <bool A_HB, class Epi>
__device__ __forceinline__ void gemm_phase(LAS unsigned char* lds, const Gemm g, const StaticOrder S, const Epi E) {
    const int tid = threadIdx.x, wid = __builtin_amdgcn_readfirstlane(tid >> 6), lane = tid & 63, wr = wid >> 2, wc = wid & 3, fr = lane & 15, fq = lane >> 4;
    const int K = g.K, nt = K / BK;
    unsigned voffA[2], voffB[2];
#pragma unroll
    for (int i = 0; i < 2; ++i) { int R, C; stage_rc(tid * 16 + i * 8192, R, C); const int Rb = (R & ~31) + perm32(R & 31);
        voffA[i] = A_HB ? (unsigned)(((C >> 5) * g.M + R) * 64 + (C & 31) * 2) : (unsigned)(R * K + C) * 2u; voffB[i] = (unsigned)(Rb * K + C) * 2u; }
    const size_t kstepB = (size_t)(BK * 2), kstepA = A_HB ? (size_t)g.M * 128 : kstepB;
    const size_t hstepB = (size_t)HALF * K * 2, hstepA = A_HB ? (size_t)HALF * 64 : hstepB;
    const size_t tstepA = 2 * hstepA, tstepB = 2 * hstepB;
    const unsigned ldsw = (unsigned)wid * 1024u;
    const int aoff = lds_byte(wr * 64 + fr, fq * 8), boff = lds_byte(wc * 32 + fr, fq * 8);
#define PG8_SA(b, h) (((b) * 2 + (h)) * HTB)
#define PG8_SB(b, h) ((4 + (b) * 2 + (h)) * HTB)
#define PG8_STAGE(bufoff, gbase, voff) do { _Pragma("unroll") for (int _i = 0; _i < 2; ++_i) \
        __builtin_amdgcn_global_load_lds((const unsigned*)((const char*)(gbase) + (voff)[_i]), (LAS unsigned*)(lds + (bufoff) + ldsw + _i * 8192), 16, 0, 0); } while (0)
#define PG8_LDA(dst, b, h) do { _Pragma("unroll") for (int m = 0; m < 4; ++m) _Pragma("unroll") for (int k = 0; k < 2; ++k) dst[m][k] = *(const LAS bf16x8*)(lds + PG8_SA(b, h) + aoff + m * 2048 + k * 1024); } while (0)
#define PG8_LDB(dst, b, h) do { _Pragma("unroll") for (int n = 0; n < 2; ++n) _Pragma("unroll") for (int k = 0; k < 2; ++k) dst[n][k] = *(const LAS bf16x8*)(lds + PG8_SB(b, h) + boff + n * 2048 + k * 1024); } while (0)
#define PG8_MMA(ai, bj, At, Bt) do { __builtin_amdgcn_s_setprio(1); _Pragma("unroll") for (int m = 0; m < 4; ++m) _Pragma("unroll") for (int n = 0; n < 2; ++n) _Pragma("unroll") for (int k = 0; k < 2; ++k) \
        acc[ai][bj][m][n] = __builtin_amdgcn_mfma_f32_16x16x32_bf16(Bt[n][k], At[m][k], acc[ai][bj][m][n], 0, 0, 0); __builtin_amdgcn_s_setprio(0); } while (0)
#define PG8_WAIT_V(n) asm volatile("s_waitcnt vmcnt(" #n ")" ::: "memory")
#define PG8_WAIT_L(n) asm volatile("s_waitcnt lgkmcnt(" #n ")" ::: "memory")
#define PG8_BAR __builtin_amdgcn_s_barrier()
#define PG8_SCHED __builtin_amdgcn_sched_barrier(0)
    Unit cur, nxt; int ui = 0;
    if (!S.next(0, cur)) return;
    f32x4 acc[2][2][4][2];
#pragma unroll
    for (int a = 0; a < 2; ++a)
#pragma unroll
        for (int b = 0; b < 2; ++b)
#pragma unroll
            for (int m = 0; m < 4; ++m)
#pragma unroll
                for (int n = 0; n < 2; ++n) acc[a][b][m][n] = (f32x4){0.f, 0.f, 0.f, 0.f};
    bf16x8 At[4][2], B0[2][2], B1[2][2];
    const char* cA = (const char*)g.A + (size_t)cur.pm * tstepA; const char* cB = (const char*)g.Bt + (size_t)cur.pn * tstepB;
    PG8_STAGE(PG8_SB(0, 0), cB, voffB); PG8_STAGE(PG8_SA(0, 0), cA, voffA); PG8_STAGE(PG8_SB(0, 1), cB + hstepB, voffB); PG8_STAGE(PG8_SA(0, 1), cA + hstepA, voffA);
    if (wr == 1) PG8_BAR;
    PG8_WAIT_V(4); PG8_BAR;
    PG8_STAGE(PG8_SB(1, 0), cB + kstepB, voffB); PG8_STAGE(PG8_SA(1, 0), cA + kstepA, voffA); PG8_STAGE(PG8_SB(1, 1), cB + hstepB + kstepB, voffB);
    PG8_WAIT_V(6); PG8_BAR;
    for (;;) {
        const bool has_next = S.next(ui + 1, nxt);
        const char* nA = has_next ? (const char*)g.A + (size_t)nxt.pm * tstepA : cA; const char* nB = has_next ? (const char*)g.Bt + (size_t)nxt.pn * tstepB : cB;
        for (int t = 0; t < nt; t += 2) {
            const bool last = (t == nt - 2);
            const char* a1 = cA + (size_t)(t + 1) * kstepA;
            const char* a2 = last ? nA : cA + (size_t)(t + 2) * kstepA; const char* b2 = last ? nB : cB + (size_t)(t + 2) * kstepB;
            const char* a3 = a2 + kstepA; const char* b3 = b2 + kstepB;
            PG8_LDB(B0, 0, 0); PG8_SCHED; PG8_LDA(At, 0, 0); PG8_STAGE(PG8_SA(1, 1), a1 + hstepA, voffA);
            PG8_WAIT_L(8); PG8_BAR; PG8_WAIT_L(0); PG8_MMA(0, 0, At, B0); PG8_BAR; PG8_SCHED;
            PG8_LDB(B1, 0, 1); PG8_STAGE(PG8_SB(0, 0), b2, voffB);
            PG8_BAR; PG8_WAIT_L(0); PG8_MMA(0, 1, At, B1); PG8_BAR;
            PG8_LDA(At, 0, 1); PG8_STAGE(PG8_SA(0, 0), a2, voffA);
            PG8_BAR; PG8_WAIT_L(0); PG8_MMA(1, 0, At, B0); PG8_BAR; PG8_SCHED;
            PG8_STAGE(PG8_SB(0, 1), b2 + hstepB, voffB);
            PG8_WAIT_V(6); PG8_BAR; PG8_MMA(1, 1, At, B1); PG8_BAR;
            PG8_LDB(B0, 1, 0); PG8_SCHED; PG8_LDA(At, 1, 0); PG8_STAGE(PG8_SA(0, 1), a2 + hstepA, voffA);
            PG8_WAIT_L(8); PG8_BAR; PG8_WAIT_L(0); PG8_MMA(0, 0, At, B0); PG8_BAR; PG8_SCHED;
            PG8_LDB(B1, 1, 1); PG8_STAGE(PG8_SB(1, 0), b3, voffB);
            PG8_BAR; PG8_WAIT_L(0); PG8_MMA(0, 1, At, B1); PG8_BAR;
            PG8_LDA(At, 1, 1); PG8_STAGE(PG8_SA(1, 0), a3, voffA);
            PG8_BAR; PG8_WAIT_L(0); PG8_MMA(1, 0, At, B0); PG8_BAR; PG8_SCHED;
            PG8_STAGE(PG8_SB(1, 1), b3 + hstepB, voffB);
            PG8_WAIT_V(6); PG8_BAR; PG8_MMA(1, 1, At, B1); PG8_BAR;
        }
        E(acc, cur, wr, wc, fr, fq);
        if (!has_next) break;
#pragma unroll
        for (int a = 0; a < 2; ++a)
#pragma unroll
            for (int b = 0; b < 2; ++b)
#pragma unroll
                for (int m = 0; m < 4; ++m)
#pragma unroll
                    for (int n = 0; n < 2; ++n) acc[a][b][m][n] = (f32x4){0.f, 0.f, 0.f, 0.f};
        cur = nxt; cA = nA; cB = nB; ++ui;
    }
    PG8_WAIT_V(0);
    if (wr == 0) PG8_BAR;
    PG8_BAR;
#undef PG8_SA
#undef PG8_SB
#undef PG8_STAGE
#undef PG8_LDA
#undef PG8_LDB
#undef PG8_MMA
#undef PG8_WAIT_V
#undef PG8_WAIT_L
#undef PG8_BAR
#undef PG8_SCHED
}
}
using pg8::Unit;
typedef f32x4 Acc[2][2][4][2];

__device__ __forceinline__ void load_rs8(const float* rss, int row0, float (&rs)[8]) {
#pragma unroll
    for (int i = 0; i < 8; ++i) rs[i] = rss[row0 + (i >> 2) * 128 + (i & 3) * 16];
#pragma unroll
    for (int i = 0; i < 8; ++i) rs[i] = rsqrtf(rs[i] * (1.0f / D) + EPS);
}
struct EpiSwiGLU {
    bf16_t* H; const float* rss;
    __device__ __forceinline__ void operator()(const Acc& acc, const Unit& u, int wr, int wc, int fr, int fq) const {
        const int row0 = u.pm * 256 + wr * 64 + fr, col0 = u.pn * 128 + wc * 32 + 8 * fq;
        float rsv[8]; load_rs8(rss, row0, rsv);
#pragma unroll
        for (int ai = 0; ai < 2; ++ai)
#pragma unroll
            for (int m = 0; m < 4; ++m) {
                const int row = row0 + ai * 128 + m * 16;
                const float rs = rsv[ai * 4 + m], nrl = -1.4426950408889634f * rs, rs2 = rs * rs;
                float h[8];
#pragma unroll
                for (int n = 0; n < 2; ++n)
#pragma unroll
                    for (int j = 0; j < 4; ++j) { const float ga = acc[ai][0][m][n][j], ua = acc[ai][1][m][n][j];
                        const float sg = __builtin_amdgcn_rcpf(1.0f + __builtin_amdgcn_exp2f(ga * nrl)); h[n * 4 + j] = (ga * ua) * rs2 * sg; }
                u32x4 w; w.x = cvt_pk_bf16(h[0], h[1]); w.y = cvt_pk_bf16(h[2], h[3]); w.z = cvt_pk_bf16(h[4], h[5]); w.w = cvt_pk_bf16(h[6], h[7]);
                *(u32x4*)(H + hb(row, col0)) = w;
            }
    }
};
template <int MODE> struct EpiResid {
    const float* base; float* out; bf16_t* xb; float* rss_out; float alpha;
    __device__ __forceinline__ void operator()(const Acc& acc, const Unit& u, int wr, int wc, int fr, int fq) const {
        const int row0 = u.pm * 256 + wr * 64 + fr, col0 = u.pn * 256 + wc * 32 + 8 * fq;
#pragma unroll
        for (int ai = 0; ai < 2; ++ai) {
            f32x4 b[4][2][2];
#pragma unroll
            for (int m = 0; m < 4; ++m)
#pragma unroll
                for (int bj = 0; bj < 2; ++bj) { const size_t off = (size_t)(row0 + ai * 128 + m * 16) * D + col0 + bj * 128;
                    if (MODE == 0) { b[m][bj][0] = *(const f32x4*)(base + off); b[m][bj][1] = *(const f32x4*)(base + off + 4); }
                    else { const u32x4 pw = *(const u32x4*)(xb + hb(row0 + ai * 128 + m * 16, col0 + bj * 128));
                        b[m][bj][0] = (f32x4){bf_lo(pw.x), bf_hi(pw.x), bf_lo(pw.y), bf_hi(pw.y)}; b[m][bj][1] = (f32x4){bf_lo(pw.z), bf_hi(pw.z), bf_lo(pw.w), bf_hi(pw.w)}; } }
#pragma unroll
            for (int m = 0; m < 4; ++m) {
                const int row = row0 + ai * 128 + m * 16; const size_t off = (size_t)row * D + col0;
                float ss = 0.f;
#pragma unroll
                for (int bj = 0; bj < 2; ++bj) {
                    const f32x4 v0 = b[m][bj][0] + alpha * acc[ai][bj][m][0], v1 = b[m][bj][1] + alpha * acc[ai][bj][m][1];
                    if (MODE == 2) { *(f32x4*)(out + off + bj * 128) = v0; *(f32x4*)(out + off + bj * 128 + 4) = v1; }
                    else {
                        u32x4 w; w.x = cvt_pk_bf16(v0[0], v0[1]); w.y = cvt_pk_bf16(v0[2], v0[3]); w.z = cvt_pk_bf16(v1[0], v1[1]); w.w = cvt_pk_bf16(v1[2], v1[3]);
                        *(u32x4*)(xb + hb(row, col0 + bj * 128)) = w;
                        const float r0 = bf_lo(w.x), r1 = bf_hi(w.x), r2 = bf_lo(w.y), r3 = bf_hi(w.y), r4 = bf_lo(w.z), r5 = bf_hi(w.z), r6 = bf_lo(w.w), r7 = bf_hi(w.w);
                        ss += (r0 * r0 + r1 * r1) + (r2 * r2 + r3 * r3) + (r4 * r4 + r5 * r5) + (r6 * r6 + r7 * r7);
                    }
                }
                if (MODE != 2) { ss += __shfl_xor(ss, 16); ss += __shfl_xor(ss, 32);
                    if (fq == 0) __hip_atomic_fetch_add(rss_out + row, ss, __ATOMIC_RELAXED, __HIP_MEMORY_SCOPE_AGENT); }
            }
            asm volatile("" ::: "memory");
        }
    }
};
struct EpiQKV {
    bf16_t* Q; const float* rss;
    __device__ __forceinline__ void operator()(const Acc& acc, const Unit& u, int wr, int wc, int fr, int fq) const {
        const int row0 = u.pm * 256 + wr * 64 + fr; const int t = u.pn / 6, colt = (u.pn - 6 * t) * 256;
        bf16_t* basep = Q + (size_t)t * ((size_t)M * AW); const int col0 = colt + wc * 32 + 8 * fq;
        float rsv[8]; load_rs8(rss, row0, rsv);
#pragma unroll
        for (int ai = 0; ai < 2; ++ai)
#pragma unroll
            for (int m = 0; m < 4; ++m) {
                const int row = row0 + ai * 128 + m * 16; const float rs = rsv[ai * 4 + m];
#pragma unroll
                for (int bj = 0; bj < 2; ++bj) { const f32x4 v0 = acc[ai][bj][m][0] * rs, v1 = acc[ai][bj][m][1] * rs;
                    u32x4 w; w.x = cvt_pk_bf16(v0[0], v0[1]); w.y = cvt_pk_bf16(v0[2], v0[3]); w.z = cvt_pk_bf16(v1[0], v1[1]); w.w = cvt_pk_bf16(v1[2], v1[3]);
                    *(u32x4*)(basep + (size_t)row * AW + col0 + bj * 128) = w; }
            }
    }
};
struct EpiCU {
    bf16_t* CU; const float* rss;
    __device__ __forceinline__ void operator()(const Acc& acc, const Unit& u, int wr, int wc, int fr, int fq) const {
        const int row0 = u.pm * 256 + wr * 64 + fr; const int col0 = u.pn * 128 + wc * 32 + 8 * fq;
        float rsv[8]; load_rs8(rss, row0, rsv);
#pragma unroll
        for (int ai = 0; ai < 2; ++ai)
#pragma unroll
            for (int m = 0; m < 4; ++m) {
                const int row = row0 + ai * 128 + m * 16; const float rs = rsv[ai * 4 + m]; const float rs2 = rs * rs;
                const f32x4 v0 = acc[ai][0][m][0] * acc[ai][1][m][0] * rs2, v1 = acc[ai][0][m][1] * acc[ai][1][m][1] * rs2;
                u32x4 w; w.x = cvt_pk_bf16(v0[0], v0[1]); w.y = cvt_pk_bf16(v0[2], v0[3]); w.z = cvt_pk_bf16(v1[0], v1[1]); w.w = cvt_pk_bf16(v1[2], v1[3]);
                *(u32x4*)(CU + hb(row, col0)) = w;
            }
    }
};
struct EpiQKVCU {
    bf16_t* Q; bf16_t* CU; const float* rss;
    __device__ __forceinline__ void operator()(const Acc& acc, const Unit& u, int wr, int wc, int fr, int fq) const {
        if (u.pn < 18) { const EpiQKV e{Q, rss}; e(acc, u, wr, wc, fr, fq); }
        else { const EpiCU e{CU, rss}; Unit v; v.pm = u.pm; v.pn = u.pn - 18; e(acc, v, wr, wc, fr, fq); }
    }
};
struct EpiGB {
    const bf16_t* CU; bf16_t* Y; unsigned char* SG; const bf16_t* CW; const float* rss;
    __device__ __forceinline__ void operator()(const Acc& acc, const Unit& u, int wr, int wc, int fr, int fq) const {
        const int row0 = u.pm * 256 + wr * 64 + fr; const int pn = u.pn;
        float rsv[8]; load_rs8(rss, row0, rsv);
        if (pn < 8) {
            const int col0 = pn * 256 + wc * 32 + 8 * fq;
#pragma unroll
            for (int bj = 0; bj < 2; ++bj) {
                const int col = col0 + bj * 128;
                const u32x4 t0 = *(const u32x4*)(CW + col), t1 = *(const u32x4*)(CW + D + col), t2 = *(const u32x4*)(CW + 2 * D + col);
#pragma unroll
                for (int ab = 0; ab < 4; ++ab) {
                    const int ai = ab >> 1, m0 = (ab & 1) * 2;
                    u32x4 c0[2], c1[2], c2[2];
#pragma unroll
                    for (int mm = 0; mm < 2; ++mm) { const int row = row0 + ai * 128 + (m0 + mm) * 16; const int tt = row & (SEQ - 1);
                        const bf16_t* p = CU + hb(row, col);
                        c0[mm] = *(const u32x4*)p; c1[mm] = *(const u32x4*)(p - (tt >= 1 ? 32 : 0)); c2[mm] = *(const u32x4*)(p - (tt >= 2 ? 64 : 0)); }
#pragma unroll
                    for (int mm = 0; mm < 2; ++mm) { const int m = m0 + mm; const int row = row0 + ai * 128 + m * 16; const int tt = row & (SEQ - 1); const float rs = rsv[ai * 4 + m];
                        const float k1 = tt >= 1 ? 1.f : 0.f, k2 = tt >= 2 ? 1.f : 0.f;
                        const f32x4 g0 = acc[ai][bj][m][0] * rs, g1 = acc[ai][bj][m][1] * rs;
                        float y[8];
#define CV(e, W, SEL, G) y[e] = (G) * (SEL(t2.W) * SEL(c0[mm].W) + k1 * SEL(t1.W) * SEL(c1[mm].W) + k2 * SEL(t0.W) * SEL(c2[mm].W))
                        CV(0, x, bf_lo, g0[0]); CV(1, x, bf_hi, g0[1]); CV(2, y, bf_lo, g0[2]); CV(3, y, bf_hi, g0[3]);
                        CV(4, z, bf_lo, g1[0]); CV(5, z, bf_hi, g1[1]); CV(6, w, bf_lo, g1[2]); CV(7, w, bf_hi, g1[3]);
#undef CV
                        u32x4 w; w.x = cvt_pk_bf16(y[0], y[1]); w.y = cvt_pk_bf16(y[2], y[3]); w.z = cvt_pk_bf16(y[4], y[5]); w.w = cvt_pk_bf16(y[6], y[7]);
                        *(u32x4*)(Y + hb(row, col)) = w; }
                    asm volatile("" ::: "memory");
                }
            }
        } else {
            const int ch0 = (pn - 8) * 128 + wc * 32 + 8 * fq;
#pragma unroll
            for (int ai = 0; ai < 2; ++ai)
#pragma unroll
                for (int m = 0; m < 4; ++m) {
                    const int row = row0 + ai * 128 + m * 16; const float rs = rsv[ai * 4 + m];
                    unsigned q[2][8];
#pragma unroll
                    for (int bj = 0; bj < 2; ++bj)
#pragma unroll
                        for (int n = 0; n < 2; ++n)
#pragma unroll
                            for (int j = 0; j < 4; ++j) q[bj][n * 4 + j] = (unsigned)__builtin_rintf(fast_sigmoid(acc[ai][bj][m][n][j] * rs) * 255.0f);
                    u32x4 w;
                    w.x = q[0][0] | (q[0][1] << 8) | (q[0][2] << 16) | (q[0][3] << 24); w.y = q[0][4] | (q[0][5] << 8) | (q[0][6] << 16) | (q[0][7] << 24);
                    w.z = q[1][0] | (q[1][1] << 8) | (q[1][2] << 16) | (q[1][3] << 24); w.w = q[1][4] | (q[1][5] << 8) | (q[1][6] << 16) | (q[1][7] << 24);
                    *(u32x4*)(SG + ((size_t)(ch0 >> 5) * M + row) * 64 + (size_t)((ch0 >> 3) & 3) * 16) = w;
                }
        }
    }
};
template <bool ADD> struct EpiMerge {
    bf16_t* MG; const bf16_t* gate;
    __device__ __forceinline__ void operator()(const Acc& acc, const Unit& u, int wr, int wc, int fr, int fq) const {
        const int row0 = u.pm * 256 + wr * 64 + fr, col0 = u.pn * 256 + wc * 32 + 8 * fq;
#pragma unroll
        for (int ai = 0; ai < 2; ++ai) {
            u32x2 gw[4][2]; u32x4 pw[4][2];
#pragma unroll
            for (int m = 0; m < 4; ++m)
#pragma unroll
                for (int bj = 0; bj < 2; ++bj) { const size_t off = (size_t)(row0 + ai * 128 + m * 16) * D + col0 + bj * 128;
                    gw[m][bj] = *(const u32x2*)((const unsigned char*)gate + ((size_t)((col0 + bj * 128) >> 5) * M + (row0 + ai * 128 + m * 16)) * 64 + (size_t)(((col0 + bj * 128) >> 3) & 3) * 16 + (ADD ? 8 : 0));
                    if (ADD) pw[m][bj] = *(const u32x4*)(MG + hb(row0 + ai * 128 + m * 16, col0 + bj * 128)); }
#pragma unroll
            for (int m = 0; m < 4; ++m)
#pragma unroll
                for (int bj = 0; bj < 2; ++bj) {
                    const size_t off = (size_t)(row0 + ai * 128 + m * 16) * D + col0 + bj * 128;
                    const u32x2 g = gw[m][bj]; constexpr float I255 = 1.0f / 255.0f;
                    f32x4 v0 = acc[ai][bj][m][0], v1 = acc[ai][bj][m][1];
                    v0[0] *= (float)(g.x & 0xffu) * I255; v0[1] *= (float)((g.x >> 8) & 0xffu) * I255; v0[2] *= (float)((g.x >> 16) & 0xffu) * I255; v0[3] *= (float)(g.x >> 24) * I255;
                    v1[0] *= (float)(g.y & 0xffu) * I255; v1[1] *= (float)((g.y >> 8) & 0xffu) * I255; v1[2] *= (float)((g.y >> 16) & 0xffu) * I255; v1[3] *= (float)(g.y >> 24) * I255;
                    if (ADD) { const u32x4 p = pw[m][bj];
                        v0[0] += bf_lo(p.x); v0[1] += bf_hi(p.x); v0[2] += bf_lo(p.y); v0[3] += bf_hi(p.y);
                        v1[0] += bf_lo(p.z); v1[1] += bf_hi(p.z); v1[2] += bf_lo(p.w); v1[3] += bf_hi(p.w); }
                    u32x4 w; w.x = cvt_pk_bf16(v0[0], v0[1]); w.y = cvt_pk_bf16(v0[2], v0[3]); w.z = cvt_pk_bf16(v1[0], v1[1]); w.w = cvt_pk_bf16(v1[2], v1[3]);
                    *(u32x4*)(MG + hb(row0 + ai * 128 + m * 16, col0 + bj * 128)) = w;
                }
            asm volatile("" ::: "memory");
        }
    }
};

__device__ __forceinline__ int map_row(int mode, int n) {
    if (mode == 0) return n;
    if (mode == 1) return (n >> 7) * 256 + (n & 127);
    if (mode == 2) return (n >> 7) * 256 + 128 + (n & 127);
    if (n < NQKV) return n;
    const int c = n - NQKV, seg = c >> 11, cc = c & 2047;
    if (seg == 0) return NQKV + (cc >> 7) * 256 + (cc & 127);
    if (seg == 2) return NQKV + (cc >> 7) * 256 + 128 + (cc & 127);
    if (seg == 1) return NQKV + 4096 + cc;
    if (seg == 3) return NQKV + 6144 + (cc >> 7) * 256 + (cc & 127);
    return NQKV + 6144 + (cc >> 7) * 256 + 128 + (cc & 127);
}
__device__ __forceinline__ void p0_item(const float* __restrict__ W, int K, int N, bf16_t* __restrict__ WT, const float* __restrict__ gain, int mode, LAS float* scr, int item, int lane) {
    const int nblk = N / 32, kb = item / nblk, nb = item - kb * nblk, k0 = 64 * kb, n0 = 32 * nb;
    const int rg = lane >> 3, c4 = (lane & 7) * 4;
    f32x4 v[8]; float gv[8];
#pragma unroll
    for (int i = 0; i < 8; ++i) { const int kk = 8 * i + rg; v[i] = *(const f32x4*)(W + (size_t)(k0 + kk) * N + n0 + c4); gv[i] = gain ? gain[k0 + kk] : 1.0f; }
#pragma unroll
    for (int i = 0; i < 8; ++i) { const int kk = 8 * i + rg; LAS float* d = scr + kk * 33 + c4; d[0] = v[i][0] * gv[i]; d[1] = v[i][1] * gv[i]; d[2] = v[i][2] * gv[i]; d[3] = v[i][3] * gv[i]; }
    LDS_WAIT();
    const int c = lane & 7; const int dr0 = map_row(mode, n0);
#pragma unroll
    for (int j = 0; j < 4; ++j) { const int n = (lane >> 3) + 8 * j; const LAS float* sp = scr + (8 * c) * 33 + n;
        u32x4 o; o.x = cvt_pk_bf16(sp[0 * 33], sp[1 * 33]); o.y = cvt_pk_bf16(sp[2 * 33], sp[3 * 33]); o.z = cvt_pk_bf16(sp[4 * 33], sp[5 * 33]); o.w = cvt_pk_bf16(sp[6 * 33], sp[7 * 33]);
        *(u32x4*)(WT + (size_t)(dr0 + n) * K + k0 + 8 * c) = o; }
    LDS_WAIT();
}

struct Args {
    const float* in[17]; float* out; unsigned char* ws; int ph_lo, ph_hi;
};

__device__ __forceinline__ void p0_phase(const Args& a, LAS unsigned char* lds, int G, int bid) {
    const int tid = threadIdx.x, lane = tid & 63, wave = tid >> 6;
    LAS float* scr = (LAS float*)(lds + wave * 8448);
    const int gw = bid * 8 + wave, NGW = G * 8;
    unsigned char* ws = a.ws;
    constexpr int I_GU = (D / 64) * (FF / 32), I_DN = (FF / 64) * (D / 32), I_IN = (D / 64) * (NIN / 32), I_AO = (AO / 64) * (D / 32), I_DD = (D / 64) * (D / 32);
    constexpr int NITEMS = 4 * I_GU + 2 * I_DN + I_IN + I_AO + 2 * I_DD;
    for (int it = gw; it < NITEMS; it += NGW) {
        int r = it;
        if (r < I_GU) { p0_item(a.in[2], D, FF, (bf16_t*)(ws + WS_W1GU), a.in[1], 1, scr, r, lane); continue; } r -= I_GU;
        if (r < I_GU) { p0_item(a.in[3], D, FF, (bf16_t*)(ws + WS_W1GU), a.in[1], 2, scr, r, lane); continue; } r -= I_GU;
        if (r < I_DN) { p0_item(a.in[4], FF, D, (bf16_t*)(ws + WS_W1D), nullptr, 0, scr, r, lane); continue; } r -= I_DN;
        if (r < I_IN) { p0_item(a.in[6], D, NIN, (bf16_t*)(ws + WS_WIN), a.in[5], 3, scr, r, lane); continue; } r -= I_IN;
        if (r < I_AO) { p0_item(a.in[10], AO, D, (bf16_t*)(ws + WS_WAO), nullptr, 0, scr, r, lane); continue; } r -= I_AO;
        if (r < I_DD) { p0_item(a.in[11], D, D, (bf16_t*)(ws + WS_WCO), nullptr, 0, scr, r, lane); continue; } r -= I_DD;
        if (r < I_DD) { p0_item(a.in[12], D, D, (bf16_t*)(ws + WS_WO), nullptr, 0, scr, r, lane); continue; } r -= I_DD;
        if (r < I_GU) { p0_item(a.in[14], D, FF, (bf16_t*)(ws + WS_W2GU), a.in[13], 1, scr, r, lane); continue; } r -= I_GU;
        if (r < I_GU) { p0_item(a.in[15], D, FF, (bf16_t*)(ws + WS_W2GU), a.in[13], 2, scr, r, lane); continue; } r -= I_GU;
        p0_item(a.in[16], FF, D, (bf16_t*)(ws + WS_W2D), nullptr, 0, scr, r, lane);
    }
    { bf16_t* CWB = (bf16_t*)(ws + WS_CWB); const float* cw = a.in[9];
      for (int i = gw * 64 + lane; i < 3 * D / 2; i += NGW * 64) ((unsigned*)CWB)[i] = cvt_pk_bf16(cw[2 * i], cw[2 * i + 1]); }
    const float* x = a.in[0]; bf16_t* XB = (bf16_t*)(ws + WS_XB); float* rss = (float*)(ws + WS_RSS);
    for (int rp = gw; rp < M / 2; rp += NGW) {
        const int row = 2 * rp + (lane >> 5), l5 = lane & 31;
        const f32x4* xr = (const f32x4*)(x + (size_t)row * D) + l5;
        f32x4 v[16]; float s = 0.f;
#pragma unroll
        for (int j = 0; j < 16; ++j) { v[j] = xr[32 * j]; s += (v[j][0] * v[j][0] + v[j][1] * v[j][1]) + (v[j][2] * v[j][2] + v[j][3] * v[j][3]); }
#pragma unroll
        for (int o = 1; o < 32; o <<= 1) s += __shfl_xor(s, o);
#pragma unroll
        for (int j = 0; j < 16; ++j) { u32x2 w; w.x = cvt_pk_bf16(v[j][0], v[j][1]); w.y = cvt_pk_bf16(v[j][2], v[j][3]); *(u32x2*)(XB + hb(row, 4 * l5 + 128 * j)) = w; }
        if (l5 == 0) { rss[row] = s; rss[M + row] = 0.f; rss[2 * M + row] = 0.f; }
    }
}

constexpr int KS_PITCH = 288, VS_PITCH = 544, VS_OFF = 256 * KS_PITCH;
__device__ __forceinline__ void attn_phase(LAS unsigned char* lds, bf16_t* Q, const bf16_t* Kg, const bf16_t* Vg, float* LSE, const float* qgain, const float* kgain, int G, int bid) {
    const int tid = threadIdx.x, wid = __builtin_amdgcn_readfirstlane(tid >> 6), lane = tid & 63, fr = lane & 15, fq = lane >> 4;
    LAS unsigned char* Ks = lds; LAS unsigned char* Vs = lds + VS_OFF;
    u32x4 kraw[8], vraw[8], qraw[4];
#define ATT_LOAD(uu) do { const int j_ = (uu) & 127, hh_ = ((uu) >> 7) % 12, b_ = (uu) / (128 * 12), g_ = hh_ >> 2; \
        const int ld_ = 2 * g_, d_ = 1 << ld_, r_ = (g_ == 2) ? (((j_ >> 6) << 3) | (j_ & 7)) : (j_ >> (7 - ld_)), n_ = (g_ == 2) ? ((j_ >> 3) & 7) : (((j_ & 7) << (4 - ld_)) | ((j_ >> 3) & ((16 >> ld_) - 1))); const size_t tok_ = (size_t)b_ * SEQ + r_; \
        _Pragma("unroll") for (int jj = 0; jj < 8; ++jj) { const int kk = (tid >> 4) + 32 * jj, ik = 128 * (n_ - 1) + kk; \
            kraw[jj] = (u32x4){0u, 0u, 0u, 0u}; if (ik >= 0) kraw[jj] = *(const u32x4*)(Kg + (tok_ + (size_t)ik * d_) * AW + hh_ * 128 + (tid & 15) * 8); } \
        _Pragma("unroll") for (int jj = 0; jj < 8; ++jj) { const int kk = (tid & 63) + 64 * (jj & 3), pc = (tid >> 6) + 8 * (jj >> 2), ik = 128 * (n_ - 1) + kk; \
            vraw[jj] = (u32x4){0u, 0u, 0u, 0u}; if (ik >= 0) vraw[jj] = *(const u32x4*)(Vg + (tok_ + (size_t)ik * d_) * AW + hh_ * 128 + pc * 8); } \
        } while (0)
    constexpr int NU = 2 * 12 * 128;
    if (bid < NU) ATT_LOAD(bid);
    for (int u = bid; u < NU; u += G) {
        const int j = u & 127, hh = (u >> 7) % 12, b = u / (128 * 12), g = hh >> 2;
        const int ld = 2 * g, d = 1 << ld, r = (g == 2) ? (((j >> 6) << 3) | (j & 7)) : (j >> (7 - ld)), n = (g == 2) ? ((j >> 3) & 7) : (((j & 7) << (4 - ld)) | ((j >> 3) & ((16 >> ld) - 1)));
        const size_t tok0 = (size_t)b * SEQ + r;
        const int qi = 16 * wid + fr; const size_t rowq = tok0 + (size_t)(128 * n + qi) * d;
#pragma unroll
        for (int ks = 0; ks < 4; ++ks) qraw[ks] = *(const u32x4*)(Q + rowq * AW + hh * 128 + 32 * ks + 8 * fq);
        __syncthreads();
        {
            const int piece = tid & 15;
            float kg[8];
#pragma unroll
            for (int e = 0; e < 8; ++e) kg[e] = kgain[hh * 128 + piece * 8 + e];
#pragma unroll
            for (int jj = 0; jj < 8; ++jj) {
                const int kk = (tid >> 4) + 32 * jj;
                const u32x4 raw = kraw[jj];
                float v[8] = {bf_lo(raw.x), bf_hi(raw.x), bf_lo(raw.y), bf_hi(raw.y), bf_lo(raw.z), bf_hi(raw.z), bf_lo(raw.w), bf_hi(raw.w)};
                float ss = 0.f;
#pragma unroll
                for (int e = 0; e < 8; ++e) ss += v[e] * v[e];
                ss += __shfl_xor(ss, 1); ss += __shfl_xor(ss, 2); ss += __shfl_xor(ss, 4); ss += __shfl_xor(ss, 8);
                const float rs = rsqrtf(ss * (1.0f / 128.0f) + EPS);
                u32x4 w; w.x = cvt_pk_bf16(v[0] * rs * kg[0], v[1] * rs * kg[1]); w.y = cvt_pk_bf16(v[2] * rs * kg[2], v[3] * rs * kg[3]);
                w.z = cvt_pk_bf16(v[4] * rs * kg[4], v[5] * rs * kg[5]); w.w = cvt_pk_bf16(v[6] * rs * kg[6], v[7] * rs * kg[7]);
                *(LAS u32x4*)(Ks + kk * KS_PITCH + piece * 16) = w;
            }
        }
        {
#pragma unroll
            for (int jj = 0; jj < 8; ++jj) {
                const int kk = (tid & 63) + 64 * (jj & 3), pc = (tid >> 6) + 8 * (jj >> 2);
                const u32x4 raw = vraw[jj];
                const int pk = (kk & ~31) + 8 * ((kk & 15) >> 2) + 4 * ((kk >> 4) & 1) + (kk & 3);
                LAS unsigned short* dst = (LAS unsigned short*)(Vs + (pc * 8) * VS_PITCH + pk * 2);
                dst[0 * (VS_PITCH / 2)] = (unsigned short)(raw.x & 0xffffu); dst[1 * (VS_PITCH / 2)] = (unsigned short)(raw.x >> 16);
                dst[2 * (VS_PITCH / 2)] = (unsigned short)(raw.y & 0xffffu); dst[3 * (VS_PITCH / 2)] = (unsigned short)(raw.y >> 16);
                dst[4 * (VS_PITCH / 2)] = (unsigned short)(raw.z & 0xffffu); dst[5 * (VS_PITCH / 2)] = (unsigned short)(raw.z >> 16);
                dst[6 * (VS_PITCH / 2)] = (unsigned short)(raw.w & 0xffffu); dst[7 * (VS_PITCH / 2)] = (unsigned short)(raw.w >> 16);
            }
        }
        bf16x8 qf[4];
        {
            float ss = 0.f;
#pragma unroll
            for (int ks = 0; ks < 4; ++ks) {
                const float v[8] = {bf_lo(qraw[ks].x), bf_hi(qraw[ks].x), bf_lo(qraw[ks].y), bf_hi(qraw[ks].y), bf_lo(qraw[ks].z), bf_hi(qraw[ks].z), bf_lo(qraw[ks].w), bf_hi(qraw[ks].w)};
#pragma unroll
                for (int e = 0; e < 8; ++e) ss += v[e] * v[e]; }
            ss += __shfl_xor(ss, 16); ss += __shfl_xor(ss, 32);
            const float rs = rsqrtf(ss * (1.0f / 128.0f) + EPS) * 0.08838834764831845f;
#pragma unroll
            for (int ks = 0; ks < 4; ++ks) {
                const float* gp = qgain + hh * 128 + 32 * ks + 8 * fq;
                const f32x4 g0 = *(const f32x4*)gp, g1 = *(const f32x4*)(gp + 4);
                u32x4 w; w.x = cvt_pk_bf16(bf_lo(qraw[ks].x) * rs * g0[0], bf_hi(qraw[ks].x) * rs * g0[1]); w.y = cvt_pk_bf16(bf_lo(qraw[ks].y) * rs * g0[2], bf_hi(qraw[ks].y) * rs * g0[3]);
                w.z = cvt_pk_bf16(bf_lo(qraw[ks].z) * rs * g1[0], bf_hi(qraw[ks].z) * rs * g1[1]); w.w = cvt_pk_bf16(bf_lo(qraw[ks].w) * rs * g1[2], bf_hi(qraw[ks].w) * rs * g1[3]);
                qf[ks] = __builtin_bit_cast(bf16x8, w);
            }
        }
        if (u + G < NU) ATT_LOAD(u + G);
        LDS_WAIT();
        __syncthreads();
        const int T0 = 2 * (wid >> 1);
        f32x4 s[10];
#pragma unroll
        for (int t = 0; t < 10; ++t) { s[t] = (f32x4){0.f, 0.f, 0.f, 0.f};
#pragma unroll
            for (int ks = 0; ks < 4; ++ks) { const bf16x8 a = *(const LAS bf16x8*)(Ks + (16 * (T0 + t) + fr) * KS_PITCH + (32 * ks + 8 * fq) * 2);
                s[t] = __builtin_amdgcn_mfma_f32_16x16x32_bf16(a, qf[ks], s[t], 0, 0, 0); } }
        const float slope = exp2f(-8.0f * (float)(hh + 1) / 12.0f) * (float)d;
        float mx = -3.0e38f;
#pragma unroll
        for (int t = 0; t < 10; ++t)
#pragma unroll
            for (int e = 0; e < 4; ++e) { const int ki = 16 * (T0 + t) + 4 * fq + e, dist = 128 + qi - ki;
                const bool valid = (dist >= 0) && (dist <= 128) && (n > 0 || ki >= 128);
                const float sv = valid ? s[t][e] - slope * (float)dist : -1.0e30f; s[t][e] = sv; mx = fmaxf(mx, sv); }
        mx = fmaxf(mx, __shfl_xor(mx, 16)); mx = fmaxf(mx, __shfl_xor(mx, 32));
        float l = 0.f;
#pragma unroll
        for (int t = 0; t < 10; ++t)
#pragma unroll
            for (int e = 0; e < 4; ++e) { const float p = __expf(s[t][e] - mx); s[t][e] = p; l += p; }
        l += __shfl_xor(l, 16); l += __shfl_xor(l, 32);
        f32x4 o[8];
#pragma unroll
        for (int dt = 0; dt < 8; ++dt) o[dt] = (f32x4){0.f, 0.f, 0.f, 0.f};
#pragma unroll
        for (int c = 0; c < 5; ++c) {
            u32x4 pw; pw.x = cvt_pk_bf16(s[2 * c][0], s[2 * c][1]); pw.y = cvt_pk_bf16(s[2 * c][2], s[2 * c][3]); pw.z = cvt_pk_bf16(s[2 * c + 1][0], s[2 * c + 1][1]); pw.w = cvt_pk_bf16(s[2 * c + 1][2], s[2 * c + 1][3]);
            const bf16x8 pb = __builtin_bit_cast(bf16x8, pw);
#pragma unroll
            for (int dt = 0; dt < 8; ++dt) { const bf16x8 a = *(const LAS bf16x8*)(Vs + (16 * dt + fr) * VS_PITCH + (32 * ((T0 >> 1) + c) + 8 * fq) * 2);
                o[dt] = __builtin_amdgcn_mfma_f32_16x16x32_bf16(a, pb, o[dt], 0, 0, 0); }
        }
        const float inv = 1.0f / l;
#pragma unroll
        for (int dt = 0; dt < 8; ++dt) { u32x2 w; w.x = cvt_pk_bf16(o[dt][0] * inv, o[dt][1] * inv); w.y = cvt_pk_bf16(o[dt][2] * inv, o[dt][3] * inv);
            *(u32x2*)(Q + rowq * AW + hh * 128 + 16 * dt + 4 * fq) = w; }
        if (fq == 0) LSE[((size_t)g * M + rowq) * 4 + (hh & 3)] = mx + __logf(l);
    }
}

#undef ATT_LOAD
__device__ __forceinline__ void combine_phase(const bf16_t* __restrict__ OG, const float* __restrict__ LSE, bf16_t* __restrict__ ATT, int G, int bid) {
    const int nthr = G * 512;
    for (int it0 = bid * 512 + threadIdx.x; it0 < M * 64; it0 += 4 * nthr) {
        float l0[4], l1[4], l2[4]; u32x4 w0[4], w1[4], w2[4];
#pragma unroll
        for (int q = 0; q < 4; ++q) { const int it = it0 + q * nthr; if (it < M * 64) {
            const int t = (it >> 2) & (M - 1), c8 = ((it >> 17) << 2) | (it & 3), h = c8 >> 4;
            l0[q] = LSE[((size_t)0 * M + t) * 4 + h]; l1[q] = LSE[((size_t)1 * M + t) * 4 + h]; l2[q] = LSE[((size_t)2 * M + t) * 4 + h];
            const bf16_t* p = OG + (size_t)t * AW + h * 128 + (c8 & 15) * 8;
            w0[q] = *(const u32x4*)p; w1[q] = *(const u32x4*)(p + 512); w2[q] = *(const u32x4*)(p + 1024); } }
#pragma unroll
        for (int q = 0; q < 4; ++q) { const int it = it0 + q * nthr; if (it < M * 64) {
            const int t = (it >> 2) & (M - 1), c8 = ((it >> 17) << 2) | (it & 3);
            const float mx = fmaxf(l0[q], fmaxf(l1[q], l2[q]));
            float a0 = __expf(l0[q] - mx), a1 = __expf(l1[q] - mx), a2 = __expf(l2[q] - mx); const float inv = 1.0f / (a0 + a1 + a2); a0 *= inv; a1 *= inv; a2 *= inv;
            const u32x4 x0 = w0[q], x1 = w1[q], x2 = w2[q];
            u32x4 o;
            o.x = cvt_pk_bf16(a0 * bf_lo(x0.x) + a1 * bf_lo(x1.x) + a2 * bf_lo(x2.x), a0 * bf_hi(x0.x) + a1 * bf_hi(x1.x) + a2 * bf_hi(x2.x));
            o.y = cvt_pk_bf16(a0 * bf_lo(x0.y) + a1 * bf_lo(x1.y) + a2 * bf_lo(x2.y), a0 * bf_hi(x0.y) + a1 * bf_hi(x1.y) + a2 * bf_hi(x2.y));
            o.z = cvt_pk_bf16(a0 * bf_lo(x0.z) + a1 * bf_lo(x1.z) + a2 * bf_lo(x2.z), a0 * bf_hi(x0.z) + a1 * bf_hi(x1.z) + a2 * bf_hi(x2.z));
            o.w = cvt_pk_bf16(a0 * bf_lo(x0.w) + a1 * bf_lo(x1.w) + a2 * bf_lo(x2.w), a0 * bf_hi(x0.w) + a1 * bf_hi(x1.w) + a2 * bf_hi(x2.w));
            *(u32x4*)(ATT + hb(t, c8 * 8)) = o; } }
    }
}

constexpr int N_PHASES = 10;
template <bool COOP>
__global__ void __launch_bounds__(512, 2) fwd_kernel(Args a) {
    extern __shared__ __attribute__((aligned(16))) unsigned char lds_raw[];
    LAS unsigned char* lds = (LAS unsigned char*)lds_raw;
    const int G = gridDim.x, bid = blockIdx.x;
    unsigned char* ws = a.ws;
    bf16_t* XB = (bf16_t*)(ws + WS_XB); float* rss = (float*)(ws + WS_RSS); bf16_t* HID = (bf16_t*)(ws + WS_HID);
    const int lo = a.ph_lo, hi = a.ph_hi;
#define IN(k) (lo <= (k) && (k) < hi)
#define SEAM(k) do { if (COOP) { if (IN(k) && IN((k) + 1)) cg::this_grid().sync(); } } while (0)
    if (IN(0)) { p0_phase(a, lds, G, bid); __syncthreads(); }
    SEAM(0);
    if (IN(1)) {
        pg8::Gemm g{XB, (const bf16_t*)(ws + WS_W1GU), M, 2 * FF, D}; pg8::StaticOrder S; S.init(M, 2 * FF, G, bid);
        EpiSwiGLU E{HID, rss};
        pg8::gemm_phase<true>(lds, g, S, E);
    }
    SEAM(1);
    if (IN(2)) {
        pg8::Gemm g{HID, (const bf16_t*)(ws + WS_W1D), M, D, FF}; pg8::StaticOrder S; S.init(M, D, G, bid);
        EpiResid<0> E{a.in[0], nullptr, XB, rss + M, 0.5f};
        pg8::gemm_phase<true>(lds, g, S, E);
    }
    SEAM(2);
    if (IN(3)) {
        pg8::Gemm g{XB, (const bf16_t*)(ws + WS_WIN), M, NQKV + 4096, D}; pg8::StaticOrder S; S.init(M, NQKV + 4096, G, bid);
        EpiQKVCU E{(bf16_t*)(ws + WS_Q), (bf16_t*)(ws + WS_CU2), rss + M};
        pg8::gemm_phase<true>(lds, g, S, E);
    }
    SEAM(3);
    if (IN(4)) attn_phase(lds, (bf16_t*)(ws + WS_Q), (const bf16_t*)(ws + WS_K), (const bf16_t*)(ws + WS_V), (float*)(ws + WS_LSE), a.in[7], a.in[8], G, bid);
    SEAM(4);
    if (IN(5)) {
        combine_phase((const bf16_t*)(ws + WS_Q), (const float*)(ws + WS_LSE), (bf16_t*)(ws + WS_ATT), G, bid);
        __syncthreads();
        pg8::Gemm g{XB, (const bf16_t*)(ws + WS_WIN) + (size_t)(NQKV + 4096) * D, M, 6144, D}; pg8::StaticOrder S; S.init(M, 6144, G, bid);
        EpiGB E{(const bf16_t*)(ws + WS_CU2), (bf16_t*)(ws + WS_GB), (unsigned char*)(ws + WS_SG8), (const bf16_t*)(ws + WS_CWB), rss + M};
        pg8::gemm_phase<true>(lds, g, S, E);
    }
    SEAM(5);
    if (IN(6)) {
        { pg8::Gemm g{(const bf16_t*)(ws + WS_ATT), (const bf16_t*)(ws + WS_WAO), M, D, AO}; pg8::StaticOrder S; S.init(M, D, G, bid);
          EpiMerge<false> E{(bf16_t*)(ws + WS_CU), (const bf16_t*)(ws + WS_SG8)};
          pg8::gemm_phase<true>(lds, g, S, E); }
        { pg8::Gemm g{(const bf16_t*)(ws + WS_GB), (const bf16_t*)(ws + WS_WCO), M, D, D}; pg8::StaticOrder S; S.init(M, D, G, bid);
          EpiMerge<true> E{(bf16_t*)(ws + WS_CU), (const bf16_t*)(ws + WS_SG8)};
          pg8::gemm_phase<true>(lds, g, S, E); }
    }
    SEAM(6);
    if (IN(7)) {
        pg8::Gemm g{(const bf16_t*)(ws + WS_CU), (const bf16_t*)(ws + WS_WO), M, D, D}; pg8::StaticOrder S; S.init(M, D, G, bid);
        EpiResid<1> E{nullptr, nullptr, XB, rss + 2 * M, 1.0f};
        pg8::gemm_phase<true>(lds, g, S, E);
    }
    SEAM(7);
    if (IN(8)) {
        pg8::Gemm g{XB, (const bf16_t*)(ws + WS_W2GU), M, 2 * FF, D}; pg8::StaticOrder S; S.init(M, 2 * FF, G, bid);
        EpiSwiGLU E{HID, rss + 2 * M};
        pg8::gemm_phase<true>(lds, g, S, E);
    }
    SEAM(8);
    if (IN(9)) {
        pg8::Gemm g{HID, (const bf16_t*)(ws + WS_W2D), M, D, FF}; pg8::StaticOrder S; S.init(M, D, G, bid);
        EpiResid<2> E{nullptr, a.out, XB, nullptr, 0.5f};
        pg8::gemm_phase<true>(lds, g, S, E);
    }
#undef IN
#undef SEAM
}

extern "C" void kernel_launch(void* const* d_in, const int* in_sizes, int n_in, void* d_out, int out_size, void* d_ws, size_t ws_size, hipStream_t stream) {
    static int grid = 0;
    constexpr bool COOP = (MULTI_LAUNCH == 0);
    if (grid == 0) {
        if (n_in != 17 || ws_size < WS_END) { fprintf(stderr, "kernel_launch: unexpected n_in %d or ws_size %zu (< %zu)\n", n_in, ws_size, (size_t)WS_END); grid = -1; return; }
        int dev = 0, cus = 0, per_cu = 0;
        hipGetDevice(&dev); hipDeviceGetAttribute(&cus, hipDeviceAttributeMultiprocessorCount, dev);
        hipFuncSetAttribute((const void*)fwd_kernel<COOP>, hipFuncAttributeMaxDynamicSharedMemorySize, LDS_BYTES);
        hipOccupancyMaxActiveBlocksPerMultiprocessor(&per_cu, (const void*)fwd_kernel<COOP>, 512, LDS_BYTES);
        if (per_cu < 1) { fprintf(stderr, "kernel_launch: occupancy query says %d blocks/CU\n", per_cu); per_cu = 1; }
        (void)hipGetLastError();
        grid = cus * 1;
    }
    if (grid < 0) return;
    Args a{};
    for (int i = 0; i < 17; ++i) a.in[i] = (const float*)d_in[i];
    a.out = (float*)d_out; a.ws = (unsigned char*)d_ws;
    if (COOP) {
        a.ph_lo = 0; a.ph_hi = N_PHASES;
        void* args[] = {&a};
        hipError_t e = hipLaunchCooperativeKernel((const void*)fwd_kernel<COOP>, dim3(grid), dim3(512), args, LDS_BYTES, stream);
        if (e != hipSuccess) fprintf(stderr, "cooperative launch failed: %s (grid %d)\n", hipGetErrorString(e), grid);
    } else {
        for (int p = 0; p < N_PHASES; ++p) {
            a.ph_lo = p; a.ph_hi = p + 1;
            hipLaunchKernelGGL(fwd_kernel<COOP>, dim3(grid), dim3(512), LDS_BYTES, stream, a);
        }
    }
}
```
